# Optimizing an MI355X kernel written in HIP

```python
import math
import jax, jax.numpy as jnp
from jax import lax
import numpy as np

D_MODEL = 2048
BATCH = 1
SEQ = 16384
DEPTH = 1

HEAD_DIM = 64
SWA_Q_HEADS = 16
SWA_KV_HEADS = 2
SWA_GROUP = SWA_Q_HEADS // SWA_KV_HEADS
SB_HEADS = 16
WINDOW = 128
BLOCK = 128
REL_BUCKETS = 32
REL_MAX_DIST = 128
D_FF = 5632
CONV_WIDTH = 3
EPS = 1e-6
NEG_INF = -1e30

SWA_Q_W = SWA_Q_HEADS * HEAD_DIM
SWA_KV_W = SWA_KV_HEADS * HEAD_DIM
SB_W = SB_HEADS * HEAD_DIM
SWA_WIDTH = SWA_Q_W
D_MIX = SWA_WIDTH + SB_W
D_IN = SWA_Q_W + 2 * SWA_KV_W + 3 * SB_W

kernel_name = "hymba_swa_sink_stickbreak_convglu"


def rmsnorm(x, g):
    xf = x.astype(jnp.float32)
    y = xf * lax.rsqrt(jnp.mean(xf * xf, axis=-1, keepdims=True) + EPS)
    return y.astype(x.dtype) * g


def rel_bucket(dist):
    max_exact = REL_BUCKETS // 2
    d = jnp.maximum(dist, 1).astype(jnp.float32)
    large = max_exact + (jnp.log(d / max_exact) / math.log(REL_MAX_DIST / max_exact)
                         * (REL_BUCKETS - max_exact)).astype(jnp.int32)
    large = jnp.minimum(large, REL_BUCKETS - 1)
    return jnp.where(dist < max_exact, dist, large)


def swa_sink_attention(qa, ka, va, rel_bias, sinks):
    B, S, _ = qa.shape
    N = S // BLOCK
    q = qa.reshape(B, N, BLOCK, SWA_KV_HEADS, SWA_GROUP, HEAD_DIM)
    k = ka.reshape(B, N, BLOCK, SWA_KV_HEADS, HEAD_DIM)
    v = va.reshape(B, N, BLOCK, SWA_KV_HEADS, HEAD_DIM)
    shift = lambda a: jnp.pad(a, ((0, 0), (1, 0), (0, 0), (0, 0), (0, 0)))[:, :-1]
    k2 = jnp.concatenate([shift(k), k], axis=2)
    v2 = jnp.concatenate([shift(v), v], axis=2)
    s = jnp.einsum('bnqhgd,bnkhd->bnhgqk', q, k2).astype(jnp.float32) * (HEAD_DIM ** -0.5)

    qi = jnp.arange(BLOCK, dtype=jnp.int32)[:, None]
    kj = jnp.arange(2 * BLOCK, dtype=jnp.int32)[None, :]
    dist = qi + BLOCK - kj
    in_win = (dist >= 0) & (dist < WINDOW)
    blk = jnp.arange(N, dtype=jnp.int32)[:, None, None]
    key_ok = (blk * BLOCK - BLOCK + kj[None]) >= 0
    valid = in_win[None] & key_ok

    bias = rel_bias[rel_bucket(jnp.clip(dist, 0, None))]
    bias = bias.transpose(2, 0, 1).reshape(SWA_KV_HEADS, SWA_GROUP, BLOCK, 2 * BLOCK)
    logits = jnp.where(valid[None, :, None, None], s + bias.astype(jnp.float32), NEG_INF)

    sink = sinks.astype(jnp.float32).reshape(1, 1, SWA_KV_HEADS, SWA_GROUP, 1, 1)
    m = jnp.maximum(logits.max(axis=-1, keepdims=True), sink)
    p = jnp.exp(logits - m)
    w = p / (p.sum(axis=-1, keepdims=True) + jnp.exp(sink - m))
    o = jnp.einsum('bnhgqk,bnkhd->bnqhgd', w.astype(v2.dtype), v2)
    return o.reshape(B, S, SWA_Q_W)


def stick_breaking_attention(qs, ks, vs):
    B, S, _ = qs.shape
    N = S // BLOCK
    q = qs.reshape(B, N, BLOCK, SB_HEADS, HEAD_DIM).transpose(1, 0, 3, 2, 4)
    k = ks.reshape(B, S, SB_HEADS, HEAD_DIM).transpose(0, 2, 1, 3)
    v = vs.reshape(B, S, SB_HEADS, HEAD_DIM).transpose(0, 2, 1, 3)
    scale = HEAD_DIM ** -0.5
    local = jnp.arange(BLOCK, dtype=jnp.int32)

    def per_query_block(args):
        qblk, n = args
        qpos = n * BLOCK + local

        def body(step, carry):
            o, acc = carry
            j = n - step
            kb = lax.dynamic_slice_in_dim(k, j * BLOCK, BLOCK, axis=2)
            vb = lax.dynamic_slice_in_dim(v, j * BLOCK, BLOCK, axis=2)
            z = jnp.einsum('bhqd,bhkd->bhqk', qblk, kb).astype(jnp.float32) * scale
            kpos = j * BLOCK + local
            causal = kpos[None, :] < qpos[:, None]
            log1m = jnp.where(causal, -jax.nn.softplus(z), 0.0)
            row = log1m.sum(axis=-1, keepdims=True)
            suffix = row - jnp.cumsum(log1m, axis=-1)
            log_a = jax.nn.log_sigmoid(z) + suffix + acc[..., None]
            a = jnp.where(causal, jnp.exp(log_a), 0.0)
            o = o + jnp.einsum('bhqk,bhkd->bhqd', a, vb.astype(jnp.float32))
            return (o, acc + row[..., 0])

        o0 = jnp.zeros(qblk.shape, jnp.float32)
        acc0 = jnp.zeros(qblk.shape[:-1], jnp.float32)
        o, _ = lax.fori_loop(0, n + 1, body, (o0, acc0))
        return o.astype(qblk.dtype)

    out = lax.map(per_query_block, (q, jnp.arange(N, dtype=jnp.int32)))
    return out.transpose(1, 0, 3, 2, 4).reshape(B, S, SB_W)


def conv_glu(h, w_up, w_conv, b_conv, w_down):
    S = h.shape[1]
    u = h @ w_up
    gate, val = u[..., :D_FF], u[..., D_FF:]
    gp = jnp.pad(gate, ((0, 0), (CONV_WIDTH - 1, 0), (0, 0)))
    gc = b_conv
    for tap in range(CONV_WIDTH):
        gc = gc + gp[:, tap:tap + S] * w_conv[tap]
    return (jax.nn.silu(gc) * val) @ w_down


def setup_inputs(seed: int = 0) -> dict:
    key = jax.random.key(seed)
    ks = jax.random.split(key, 16)
    nrm = lambda k, shape, scale: jax.random.normal(k, shape, jnp.float32) * scale
    return {
        "x": nrm(ks[0], (BATCH, SEQ, D_MODEL), 1.0),
        "w_in": nrm(ks[1], (D_MODEL, D_IN), D_MODEL ** -0.5),
        "g_attn_norm": 1.0 + nrm(ks[2], (D_MODEL,), 0.02),
        "rel_bias": nrm(ks[3], (REL_BUCKETS, SWA_Q_HEADS), 0.2),
        "swa_sinks": nrm(ks[4], (SWA_Q_HEADS,), 0.5),
        "g_swa_out": 1.0 + nrm(ks[5], (SWA_WIDTH,), 0.02),
        "g_sb_out": 1.0 + nrm(ks[6], (SB_W,), 0.02),
        "w_out": nrm(ks[7], (D_MIX, D_MODEL), D_MIX ** -0.5),
        "g_mlp_norm": 1.0 + nrm(ks[8], (D_MODEL,), 0.02),
        "w_up": nrm(ks[9], (D_MODEL, 2 * D_FF), D_MODEL ** -0.5),
        "w_conv": nrm(ks[10], (CONV_WIDTH, D_FF), CONV_WIDTH ** -0.5),
        "b_conv": nrm(ks[11], (D_FF,), 0.01),
        "w_down": nrm(ks[12], (D_FF, D_MODEL), D_FF ** -0.5),
        "g_final": 1.0 + nrm(ks[13], (D_MODEL,), 0.02),
    }


def reference(x, w_in, g_attn_norm, rel_bias, swa_sinks, g_swa_out, g_sb_out, w_out,
              g_mlp_norm, w_up, w_conv, b_conv, w_down, g_final):
    h = x
    splits = np.cumsum([SWA_Q_W, SWA_KV_W, SWA_KV_W, SB_W, SB_W]).tolist()
    for _ in range(DEPTH):
        hn = rmsnorm(h, g_attn_norm)
        proj = hn @ w_in
        qa, ka, va, qs, ks_, vs = jnp.split(proj, splits, axis=-1)
        ya = swa_sink_attention(qa, ka, va, rel_bias, swa_sinks)
        yb = stick_breaking_attention(qs, ks_, vs)
        mix = jnp.concatenate([rmsnorm(ya, g_swa_out), rmsnorm(yb, g_sb_out)], axis=-1)
        h = h + mix @ w_out
        h = h + conv_glu(rmsnorm(h, g_mlp_norm), w_up, w_conv, b_conv, w_down)
    return rmsnorm(h, g_final)
```

```cpp
#include <hip/hip_runtime.h>
#include <cstdint>
#include <cstdio>

namespace {
constexpr int M = 16384, DM = 2048, DIN = 4352, DFF = 5632, HD = 64;
constexpr int QA_OFF = 0, KA_OFF = 1024, VA_OFF = 1152, QS_OFF = 1280, KS_OFF = 2304, VS_OFF = 3328;
constexpr float EPS = 1e-6f;

typedef unsigned short bf16;
typedef short bf16x8 __attribute__((ext_vector_type(8)));
typedef float f32x4 __attribute__((ext_vector_type(4)));
typedef unsigned u32x4 __attribute__((ext_vector_type(4)));

__device__ __forceinline__ unsigned f2bf(float f) { unsigned u = __builtin_bit_cast(unsigned, f); return (u + 0x7fffu + ((u >> 16) & 1u)) >> 16; }
__device__ __forceinline__ float bf2f(unsigned h) { return __builtin_bit_cast(float, h << 16); }
__device__ __forceinline__ float wave_sum(float v) {
#pragma unroll
    for (int o = 1; o < 64; o <<= 1) v += __shfl_xor(v, o);
    return v;
}

__device__ const unsigned char kBucket[128] = {
    0, 1, 2, 3, 4, 5, 6, 7, 8, 9, 10, 11, 12, 13, 14, 15, 16, 16, 16, 17, 17, 18, 18, 18, 19, 19, 19, 20, 20, 20, 20, 21, 21, 21, 21, 22, 22, 22, 22, 22, 23, 23, 23, 23, 23, 23, 24, 24, 24, 24, 24, 24, 25, 25, 25, 25, 25, 25, 25, 26, 26, 26, 26, 26, 26, 26, 26, 27, 27, 27, 27, 27, 27, 27, 27, 27, 27, 28, 28, 28, 28, 28, 28, 28, 28, 28, 28, 29, 29, 29, 29, 29, 29, 29, 29, 29, 29, 29, 29, 30, 30, 30, 30, 30, 30, 30, 30, 30, 30, 30, 30, 30, 30, 31, 31, 31, 31, 31, 31, 31, 31, 31, 31, 31, 31, 31, 31, 31};

__global__ void __launch_bounds__(256) k_row_cvt(const float* __restrict__ x, bf16* __restrict__ xb, float* __restrict__ rstd) {
    const int lane = threadIdx.x & 63, row = blockIdx.x * 4 + (threadIdx.x >> 6);
    const f32x4* xr = (const f32x4*)(x + (size_t)row * DM) + lane;
    f32x4 v[8]; float s = 0.f;
#pragma unroll
    for (int j = 0; j < 8; ++j) { v[j] = xr[64 * j]; s += (v[j].x * v[j].x + v[j].y * v[j].y) + (v[j].z * v[j].z + v[j].w * v[j].w); }
    s = wave_sum(s);
    if (lane == 0) rstd[row] = 1.0f / sqrtf(s * (1.0f / DM) + EPS);
    unsigned long long* o8 = (unsigned long long*)(xb + (size_t)row * DM) + lane;
#pragma unroll
    for (int j = 0; j < 8; ++j) o8[64 * j] = (unsigned long long)(f2bf(v[j].x) | (f2bf(v[j].y) << 16)) | ((unsigned long long)(f2bf(v[j].z) | (f2bf(v[j].w) << 16)) << 32);
}
__global__ void __launch_bounds__(256) k_row_rstd(const float* __restrict__ x, float* __restrict__ rstd, bf16* __restrict__ xb) {
    const int lane = threadIdx.x & 63, row = blockIdx.x * 4 + (threadIdx.x >> 6);
    const f32x4* xr = (const f32x4*)(x + (size_t)row * DM) + lane;
    f32x4 v[8]; float s = 0.f;
#pragma unroll
    for (int j = 0; j < 8; ++j) { v[j] = xr[64 * j]; s += (v[j].x * v[j].x + v[j].y * v[j].y) + (v[j].z * v[j].z + v[j].w * v[j].w); }
    s = wave_sum(s);
    if (lane == 0) rstd[row] = 1.0f / sqrtf(s * (1.0f / DM) + EPS);
    unsigned long long* o8 = (unsigned long long*)(xb + (size_t)row * DM) + lane;
#pragma unroll
    for (int j = 0; j < 8; ++j) o8[64 * j] = (unsigned long long)(f2bf(v[j].x) | (f2bf(v[j].y) << 16)) | ((unsigned long long)(f2bf(v[j].z) | (f2bf(v[j].w) << 16)) << 32);
}
__global__ void __launch_bounds__(256) k_final_norm(float* __restrict__ out, const float* __restrict__ g) {
    const int lane = threadIdx.x & 63, row = blockIdx.x * 4 + (threadIdx.x >> 6);
    f32x4* xr = (f32x4*)(out + (size_t)row * DM) + lane;
    const f32x4* gr = (const f32x4*)g + lane;
    f32x4 v[8]; float s = 0.f;
#pragma unroll
    for (int j = 0; j < 8; ++j) { v[j] = xr[64 * j]; s += (v[j].x * v[j].x + v[j].y * v[j].y) + (v[j].z * v[j].z + v[j].w * v[j].w); }
    s = wave_sum(s);
    const float r = 1.0f / sqrtf(s * (1.0f / DM) + EPS);
#pragma unroll
    for (int j = 0; j < 8; ++j) { const f32x4 gg = gr[64 * j]; xr[64 * j] = v[j] * r * gg; }
}

struct EpiProj { bf16* out; const float* rstd; };
struct EpiOut { const float* x; float* h; };
struct EpiUp { bf16* gate; bf16* val; const float* rstd; };
struct EpiDown { float* h; };

__device__ __forceinline__ void epi_store(const EpiProj& e, int r, int c, float v) { e.out[(size_t)r * DIN + c] = (bf16)f2bf(v * e.rstd[r]); }
__device__ __forceinline__ void epi_store(const EpiOut& e, int r, int c, float v) { e.h[(size_t)r * DM + c] = e.x[(size_t)r * DM + c] + v; }
__device__ __forceinline__ void epi_store(const EpiUp& e, int r, int c, float v) { v *= e.rstd[r]; if (c < DFF) e.gate[(size_t)r * DFF + c] = (bf16)f2bf(v); else e.val[(size_t)r * DFF + c - DFF] = (bf16)f2bf(v); }
__device__ __forceinline__ void epi_store(const EpiDown& e, int r, int c, float v) { e.h[(size_t)r * DM + c] += v; }

template <class Epi>
__global__ void __launch_bounds__(256) k_gemm(const bf16* __restrict__ A, const float* __restrict__ W, const float* __restrict__ g, int N, int K, Epi epi) {
    __shared__ __attribute__((aligned(16))) bf16 sA[64][40];
    __shared__ __attribute__((aligned(16))) bf16 sB[64][40];
    const int tid = threadIdx.x, lane = tid & 63, w = tid >> 6, wr = w >> 1, wc = w & 1;
    const int m0 = blockIdx.y * 64, n0 = blockIdx.x * 64;
    f32x4 acc[2][2];
#pragma unroll
    for (int i = 0; i < 2; ++i)
#pragma unroll
        for (int j = 0; j < 2; ++j) acc[i][j] = (f32x4){0.f, 0.f, 0.f, 0.f};
    const int ar = tid >> 2, ac = (tid & 3) * 8;
    const int bk = tid >> 3, bn = (tid & 7) * 8;
    for (int k0 = 0; k0 < K; k0 += 32) {
        const u32x4 av = *(const u32x4*)(A + (size_t)(m0 + ar) * K + k0 + ac);
        const f32x4 b0 = *(const f32x4*)(W + (size_t)(k0 + bk) * N + n0 + bn), b1 = *(const f32x4*)(W + (size_t)(k0 + bk) * N + n0 + bn + 4);
        const float gs = g ? g[k0 + bk] : 1.0f;
        __syncthreads();
        *(u32x4*)&sA[ar][ac] = av;
        sB[bn + 0][bk] = (bf16)f2bf(b0.x * gs); sB[bn + 1][bk] = (bf16)f2bf(b0.y * gs); sB[bn + 2][bk] = (bf16)f2bf(b0.z * gs); sB[bn + 3][bk] = (bf16)f2bf(b0.w * gs);
        sB[bn + 4][bk] = (bf16)f2bf(b1.x * gs); sB[bn + 5][bk] = (bf16)f2bf(b1.y * gs); sB[bn + 6][bk] = (bf16)f2bf(b1.z * gs); sB[bn + 7][bk] = (bf16)f2bf(b1.w * gs);
        __syncthreads();
        bf16x8 af[2], bfr[2];
#pragma unroll
        for (int i = 0; i < 2; ++i) { af[i] = *(const bf16x8*)&sA[wr * 32 + i * 16 + (lane & 15)][(lane >> 4) * 8]; bfr[i] = *(const bf16x8*)&sB[wc * 32 + i * 16 + (lane & 15)][(lane >> 4) * 8]; }
#pragma unroll
        for (int i = 0; i < 2; ++i)
#pragma unroll
            for (int j = 0; j < 2; ++j) acc[i][j] = __builtin_amdgcn_mfma_f32_16x16x32_bf16(af[i], bfr[j], acc[i][j], 0, 0, 0);
    }
#pragma unroll
    for (int i = 0; i < 2; ++i)
#pragma unroll
        for (int j = 0; j < 2; ++j)
#pragma unroll
            for (int e = 0; e < 4; ++e) epi_store(epi, m0 + wr * 32 + i * 16 + (lane >> 4) * 4 + e, n0 + wc * 32 + j * 16 + (lane & 15), acc[i][j][e]);
}

__device__ __forceinline__ void load_row64(const bf16* p, float* d) {
#pragma unroll
    for (int c = 0; c < 8; ++c) { const u32x4 v = *(const u32x4*)(p + c * 8);
        d[c * 8 + 0] = bf2f(v.x & 0xffffu); d[c * 8 + 1] = bf2f(v.x >> 16); d[c * 8 + 2] = bf2f(v.y & 0xffffu); d[c * 8 + 3] = bf2f(v.y >> 16);
        d[c * 8 + 4] = bf2f(v.z & 0xffffu); d[c * 8 + 5] = bf2f(v.z >> 16); d[c * 8 + 6] = bf2f(v.w & 0xffffu); d[c * 8 + 7] = bf2f(v.w >> 16); }
}
__device__ __forceinline__ float dot_row64(const bf16* p, const float* q) {
    float s = 0.f;
#pragma unroll
    for (int c = 0; c < 8; ++c) { const u32x4 v = *(const u32x4*)(p + c * 8);
        s += q[c * 8 + 0] * bf2f(v.x & 0xffffu); s += q[c * 8 + 1] * bf2f(v.x >> 16); s += q[c * 8 + 2] * bf2f(v.y & 0xffffu); s += q[c * 8 + 3] * bf2f(v.y >> 16);
        s += q[c * 8 + 4] * bf2f(v.z & 0xffffu); s += q[c * 8 + 5] * bf2f(v.z >> 16); s += q[c * 8 + 6] * bf2f(v.w & 0xffffu); s += q[c * 8 + 7] * bf2f(v.w >> 16); }
    return s;
}
__device__ __forceinline__ void axpy_row64(const bf16* p, float a, float* o) {
#pragma unroll
    for (int c = 0; c < 8; ++c) { const u32x4 v = *(const u32x4*)(p + c * 8);
        o[c * 8 + 0] += a * bf2f(v.x & 0xffffu); o[c * 8 + 1] += a * bf2f(v.x >> 16); o[c * 8 + 2] += a * bf2f(v.y & 0xffffu); o[c * 8 + 3] += a * bf2f(v.y >> 16);
        o[c * 8 + 4] += a * bf2f(v.z & 0xffffu); o[c * 8 + 5] += a * bf2f(v.z >> 16); o[c * 8 + 6] += a * bf2f(v.w & 0xffffu); o[c * 8 + 7] += a * bf2f(v.w >> 16); }
}
__global__ void __launch_bounds__(64) k_swa(const bf16* __restrict__ proj, const float* __restrict__ rel_bias, const float* __restrict__ sinks, float* __restrict__ ya) {
    const int t = blockIdx.x * 64 + threadIdx.x, h = blockIdx.y, kvh = h >> 3;
    float q[64], o[64];
    load_row64(proj + (size_t)t * DIN + QA_OFF + h * HD, q);
#pragma unroll
    for (int d = 0; d < 64; ++d) o[d] = 0.f;
    const float sink = sinks[h];
    float m = sink, l = 1.0f;
    const int j0 = t - 127 < 0 ? 0 : t - 127;
    for (int j = j0; j <= t; ++j) {
        const float s = dot_row64(proj + (size_t)j * DIN + KA_OFF + kvh * HD, q) * 0.125f + rel_bias[kBucket[t - j] * 16 + h];
        const float mn = fmaxf(m, s), f = expf(m - mn), p = expf(s - mn);
        l = l * f + p;
#pragma unroll
        for (int d = 0; d < 64; ++d) o[d] *= f;
        axpy_row64(proj + (size_t)j * DIN + VA_OFF + kvh * HD, p, o);
        m = mn;
    }
    const float inv = 1.0f / l;
    float* dst = ya + (size_t)t * 1024 + h * HD;
#pragma unroll
    for (int d = 0; d < 64; d += 4) *(f32x4*)(dst + d) = (f32x4){o[d] * inv, o[d + 1] * inv, o[d + 2] * inv, o[d + 3] * inv};
}
__device__ __forceinline__ float softplus_f(float z) { return fmaxf(z, 0.f) + log1pf(expf(-fabsf(z))); }
__global__ void __launch_bounds__(64) k_sb(const bf16* __restrict__ proj, float* __restrict__ yb) {
    const int t = blockIdx.x * 64 + threadIdx.x, h = blockIdx.y;
    float q[64], o[64];
    load_row64(proj + (size_t)t * DIN + QS_OFF + h * HD, q);
#pragma unroll
    for (int d = 0; d < 64; ++d) o[d] = 0.f;
    float run = 0.f;
    for (int s = t - 1; s >= 0 && run > -104.0f; --s) {
        const float z = dot_row64(proj + (size_t)s * DIN + KS_OFF + h * HD, q) * 0.125f;
        const float sp = softplus_f(z);
        const float a = expf((z - sp) + run);
        axpy_row64(proj + (size_t)s * DIN + VS_OFF + h * HD, a, o);
        run -= sp;
    }
    float* dst = yb + (size_t)t * 1024 + h * HD;
#pragma unroll
    for (int d = 0; d < 64; d += 4) *(f32x4*)(dst + d) = (f32x4){o[d], o[d + 1], o[d + 2], o[d + 3]};
}
__global__ void __launch_bounds__(256) k_groupnorm(const float* __restrict__ ya, const float* __restrict__ yb, const float* __restrict__ gA, const float* __restrict__ gB, bf16* __restrict__ mix) {
    const int lane = threadIdx.x & 63, row = blockIdx.x * 4 + (threadIdx.x >> 6);
#pragma unroll
    for (int grp = 0; grp < 2; ++grp) {
        const f32x4* yr = (const f32x4*)((grp ? yb : ya) + (size_t)row * 1024) + lane; const f32x4* gr = (const f32x4*)(grp ? gB : gA) + lane;
        f32x4 v[4]; float s = 0.f;
#pragma unroll
        for (int j = 0; j < 4; ++j) { v[j] = yr[64 * j]; s += (v[j].x * v[j].x + v[j].y * v[j].y) + (v[j].z * v[j].z + v[j].w * v[j].w); }
        s = wave_sum(s);
        const float r = 1.0f / sqrtf(s * (1.0f / 1024) + EPS);
        unsigned long long* o8 = (unsigned long long*)(mix + (size_t)row * DM + grp * 1024) + lane;
#pragma unroll
        for (int j = 0; j < 4; ++j) { const f32x4 gg = gr[64 * j]; const f32x4 u = v[j] * r * gg;
            o8[64 * j] = (unsigned long long)(f2bf(u.x) | (f2bf(u.y) << 16)) | ((unsigned long long)(f2bf(u.z) | (f2bf(u.w) << 16)) << 32); }
    }
}
__global__ void __launch_bounds__(256) k_convglu(const bf16* __restrict__ gate, bf16* __restrict__ val, const float* __restrict__ wc, const float* __restrict__ bc) {
    const size_t idx = (size_t)blockIdx.x * 256 + threadIdx.x;
    const int t = (int)(idx / DFF), c = (int)(idx % DFF);
    float gcv = bc[c] + bf2f(gate[idx]) * wc[2 * DFF + c];
    if (t >= 1) gcv += bf2f(gate[idx - DFF]) * wc[1 * DFF + c];
    if (t >= 2) gcv += bf2f(gate[idx - 2 * DFF]) * wc[0 * DFF + c];
    const float sl = gcv / (1.0f + expf(-gcv));
    val[idx] = (bf16)f2bf(sl * bf2f(val[idx]));
}
}

extern "C" void kernel_launch(void* const* d_in, const int* in_sizes, int n_in, void* d_out, int out_size, void* d_ws, size_t ws_size, hipStream_t stream) {
    const float* x = (const float*)d_in[0]; const float* w_in = (const float*)d_in[1]; const float* g_attn = (const float*)d_in[2]; const float* rel_bias = (const float*)d_in[3];
    const float* sinks = (const float*)d_in[4]; const float* g_swa = (const float*)d_in[5]; const float* g_sb = (const float*)d_in[6]; const float* w_out = (const float*)d_in[7];
    const float* g_mlp = (const float*)d_in[8]; const float* w_up = (const float*)d_in[9]; const float* w_conv = (const float*)d_in[10]; const float* b_conv = (const float*)d_in[11];
    const float* w_down = (const float*)d_in[12]; const float* g_final = (const float*)d_in[13];
    float* out = (float*)d_out; unsigned char* ws = (unsigned char*)d_ws;
    constexpr size_t MiB = 1u << 20;
    float* rstd1 = (float*)(ws + 0); float* rstd2 = (float*)(ws + 65536 * 2);
    bf16* xb = (bf16*)(ws + 1 * MiB);
    bf16* proj = (bf16*)(ws + 65 * MiB);
    bf16* mix = (bf16*)(ws + 201 * MiB);
    float* ya = (float*)(ws + 265 * MiB);
    float* yb = (float*)(ws + 329 * MiB);
    bf16* gate = (bf16*)(ws + 65 * MiB);
    bf16* val = (bf16*)(ws + 241 * MiB);
    k_row_cvt<<<M / 4, 256, 0, stream>>>(x, xb, rstd1);
    k_gemm<EpiProj><<<dim3(DIN / 64, M / 64), 256, 0, stream>>>(xb, w_in, g_attn, DIN, DM, EpiProj{proj, rstd1});
    k_swa<<<dim3(M / 64, 16), 64, 0, stream>>>(proj, rel_bias, sinks, ya);
    k_sb<<<dim3(M / 64, 16), 64, 0, stream>>>(proj, yb);
    k_groupnorm<<<M / 4, 256, 0, stream>>>(ya, yb, g_swa, g_sb, mix);
    k_gemm<EpiOut><<<dim3(DM / 64, M / 64), 256, 0, stream>>>(mix, w_out, nullptr, DM, DM, EpiOut{x, out});
    k_row_rstd<<<M / 4, 256, 0, stream>>>(out, rstd2, xb);
    k_gemm<EpiUp><<<dim3(2 * DFF / 64, M / 64), 256, 0, stream>>>(xb, w_up, g_mlp, 2 * DFF, DM, EpiUp{gate, val, rstd2});
    k_convglu<<<(unsigned)((size_t)M * DFF / 256), 256, 0, stream>>>(gate, val, w_conv, b_conv);
    k_gemm<EpiDown><<<dim3(DM / 64, M / 64), 256, 0, stream>>>(val, w_down, nullptr, DM, DFF, EpiDown{out});
    k_final_norm<<<M / 4, 256, 0, stream>>>(out, g_final);
}
```

```cpp
#include <hip/hip_runtime.h>
#include <cstdint>
#include <cstdio>

namespace pg8 {
#define PG8_LAS __attribute__((address_space(3)))
#define PG8_GAS __attribute__((address_space(1)))
typedef unsigned short bf16_t;
typedef short bf16x8 __attribute__((ext_vector_type(8)));
typedef float f32x4 __attribute__((ext_vector_type(4)));
typedef unsigned u32x4 __attribute__((ext_vector_type(4)));
typedef unsigned u32x2 __attribute__((ext_vector_type(2)));
constexpr int BM = 256, BK = 64, HALF = 128, HTB = HALF * BK * 2  , STAGE_BYTES = 8 * HTB, NXCD = 8, WGM = 8;

__host__ __device__ __forceinline__ int lds_byte(int r, int c) { const int st = (r >> 4) * 2 + (c >> 5), rr = r & 15, cc = c & 31, ob = rr * 64 + cc * 2; return st * 1024 + (ob ^ (((ob >> 9) & 1) << 5)); }
__host__ __device__ __forceinline__ void stage_rc(int b, int& R, int& C) { const int st = b / 1024, sb = b % 1024, swz = sb ^ (((sb >> 9) & 1) << 5); R = (st >> 1) * 16 + swz / 64; C = (st & 1) * 32 + (swz % 64) / 2; }
__host__ __device__ __forceinline__ int perm32(int rho) { const int n = rho >> 4, i = rho & 15; return 8 * (i >> 2) + 4 * n + (i & 3); }

struct Unit { int pm, pn; };
struct Gemm { const bf16_t* A; const bf16_t* Bt; int M, N, K; };

struct StaticOrder {
    int nM, nN, nwg, G, c;
    __host__ __device__ void init(int M, int N, int G_, int c_) { nM = M / BM; nN = N / BM; nwg = nM * nN; G = G_; c = c_; }
    __host__ __device__ bool next(int i, Unit& u) const {
        const long L = (long)i * G + c; if (L >= nwg) return false;
        int wgid = (int)L; { const int q = nwg / NXCD, r = nwg % NXCD, xcd = wgid % NXCD, off = wgid / NXCD; wgid = (xcd < r ? xcd * (q + 1) : r * (q + 1) + (xcd - r) * q) + off; }
        const int nig = WGM * nN, gid = wgid / nig, fm = gid * WGM, gsz = (nM - fm) < WGM ? (nM - fm) : WGM;
        u.pm = fm + ((wgid % nig) % gsz); u.pn = (wgid % nig) / gsz; return true;
    }
    __device__ __forceinline__ void a_ready(const Unit&) const {}
    __device__ __forceinline__ void done(const Unit&) const {}
};

__device__ __forceinline__ unsigned cvt_pk_bf16(float lo, float hi) { unsigned r; asm volatile("v_cvt_pk_bf16_f32 %0, %1, %2" : "=v"(r) : "v"(lo), "v"(hi)); return r; }

struct EpiRowScaleBf16 {
    static constexpr bool PERM = true, AFTER_DRAIN = false;
    bf16_t* O; bf16_t* O2; int ldc; int split_pn; const float* rs; const float* slots;
    __device__ __forceinline__ void operator()(const f32x4 (&acc)[2][2][4][2], const Unit& u, int wr, int wc, int fr, int fq) const {
        const int row0 = u.pm * BM + wr * 64 + fr; int pn = u.pn; bf16_t* base = O;
        if (pn >= split_pn) { pn -= split_pn; base = O2; }
        const int col0 = pn * BM + wc * 32 + 8 * fq;
        float sc[2][4];
#pragma unroll
        for (int ai = 0; ai < 2; ++ai)
#pragma unroll
            for (int m = 0; m < 4; ++m) {
                const int r = row0 + ai * HALF + m * 16;
                if (rs) sc[ai][m] = *(const PG8_GAS float*)(rs + r);
                else { const PG8_GAS f32x4* sp = (const PG8_GAS f32x4*)(slots + (size_t)r * 32 + fq * 8); const f32x4 a = sp[0], b = sp[1];
                    float s = ((a[0] + a[1]) + (a[2] + a[3])) + ((b[0] + b[1]) + (b[2] + b[3])); s += __shfl_xor(s, 16); s += __shfl_xor(s, 32);
                    sc[ai][m] = 1.0f / sqrtf(s * (1.0f / 2048.0f) + 1e-6f); }
            }
#pragma unroll
        for (int ai = 0; ai < 2; ++ai)
#pragma unroll
            for (int m = 0; m < 4; ++m) { bf16_t* rowp = base + (size_t)(row0 + ai * HALF + m * 16) * ldc + col0; const float s = sc[ai][m];
#pragma unroll
                for (int bj = 0; bj < 2; ++bj) { const f32x4 v0 = acc[ai][bj][m][0] * s, v1 = acc[ai][bj][m][1] * s;
                    u32x4 w; w.x = cvt_pk_bf16(v0[0], v0[1]); w.y = cvt_pk_bf16(v0[2], v0[3]); w.z = cvt_pk_bf16(v1[0], v1[1]); w.w = cvt_pk_bf16(v1[2], v1[3]);
                    *(u32x4*)(rowp + bj * HALF) = w; } }
    }
};
struct EpiResidual {
    static constexpr bool PERM = false, AFTER_DRAIN = false;
    const float* base; float* out; bf16_t* ob; int ldc; float* slots;
    __device__ __forceinline__ void operator()(const f32x4 (&acc)[2][2][4][2], const Unit& u, int wr, int wc, int fr, int fq) const {
        const int row0 = u.pm * BM + wr * 64 + fr, col0 = u.pn * BM + wc * 32 + 4 * fq;
#pragma unroll
        for (int ai = 0; ai < 2; ++ai)
#pragma unroll
            for (int m = 0; m < 4; ++m) { const int r = row0 + ai * HALF + m * 16; const size_t off = (size_t)r * ldc + col0; float ss = 0.f;
#pragma unroll
                for (int bj = 0; bj < 2; ++bj)
#pragma unroll
                    for (int n = 0; n < 2; ++n) { const f32x4 v = *(const f32x4*)(base + off + bj * HALF + n * 16) + acc[ai][bj][m][n];
                        *(f32x4*)(out + off + bj * HALF + n * 16) = v; ss += (v[0] * v[0] + v[1] * v[1]) + (v[2] * v[2] + v[3] * v[3]);
                        if (ob) { u32x2 w; w.x = cvt_pk_bf16(v[0], v[1]); w.y = cvt_pk_bf16(v[2], v[3]); *(u32x2*)(ob + off + bj * HALF + n * 16) = w; } }
                ss += __shfl_xor(ss, 16); ss += __shfl_xor(ss, 32);
                if (fq == 0) slots[(size_t)r * 32 + u.pn * 4 + wc] = ss; }
    }
};

template <class Epi, class Sched, bool ALIGN_EPI = false, bool SP2 = false>
__device__ __forceinline__ void gemm_phase(PG8_LAS unsigned char* lds, const Gemm g, const Sched& S, const Epi& E) {
    const int tid = threadIdx.x, wid = __builtin_amdgcn_readfirstlane(tid >> 6), lane = tid & 63, wr = wid >> 2, wc = wid & 3, fr = lane & 15, fq = lane >> 4;
    const int K = g.K, nt = K / BK;
    unsigned voffA[2], voffB[2];
#pragma unroll
    for (int i = 0; i < 2; ++i) { int R, C; stage_rc(tid * 16 + i * 8192, R, C); const int Rb = Epi::PERM ? ((R & ~31) + perm32(R & 31)) : R;
        voffA[i] = (unsigned)(R * K + C) * 2u; voffB[i] = (unsigned)(Rb * K + C) * 2u; }
    const size_t kstep = (size_t)(BK * 2);
    const size_t hstep = (size_t)HALF * K * 2;
    const size_t tstep = 2 * hstep;
    const unsigned ldsw = (unsigned)wid * 1024u;
    const int aoff = lds_byte(wr * 64 + fr, fq * 8), boff = lds_byte(wc * 32 + fr, fq * 8);
#define PG8_SA(b, h) (((b) * 2 + (h)) * HTB)
#define PG8_SB(b, h) ((4 + (b) * 2 + (h)) * HTB)
#define PG8_STAGE(bufoff, gbase, voff) do { _Pragma("unroll") for (int _i = 0; _i < 2; ++_i) \
        __builtin_amdgcn_global_load_lds((const unsigned*)((const char*)(gbase) + (voff)[_i]), (PG8_LAS unsigned*)(lds + (bufoff) + ldsw + _i * 8192), 16, 0, 0); } while (0)
#define PG8_LDA(dst, b, h) do { _Pragma("unroll") for (int m = 0; m < 4; ++m) _Pragma("unroll") for (int k = 0; k < 2; ++k) dst[m][k] = *(const PG8_LAS bf16x8*)(lds + PG8_SA(b, h) + aoff + m * 2048 + k * 1024); } while (0)
#define PG8_LDB(dst, b, h) do { _Pragma("unroll") for (int n = 0; n < 2; ++n) _Pragma("unroll") for (int k = 0; k < 2; ++k) dst[n][k] = *(const PG8_LAS bf16x8*)(lds + PG8_SB(b, h) + boff + n * 2048 + k * 1024); } while (0)
#define PG8_MMA(ai, bj, At, Bt) do { __builtin_amdgcn_s_setprio(1); _Pragma("unroll") for (int m = 0; m < 4; ++m) _Pragma("unroll") for (int n = 0; n < 2; ++n) _Pragma("unroll") for (int k = 0; k < 2; ++k) \
        acc[ai][bj][m][n] = __builtin_amdgcn_mfma_f32_16x16x32_bf16(Bt[n][k], At[m][k], acc[ai][bj][m][n], 0, 0, 0); __builtin_amdgcn_s_setprio(0); } while (0)
#define PG8_WAIT_V(n) asm volatile("s_waitcnt vmcnt(" #n ")" ::: "memory")
#define PG8_WAIT_L(n) asm volatile("s_waitcnt lgkmcnt(" #n ")" ::: "memory")
#define PG8_BAR __builtin_amdgcn_s_barrier()
#define PG8_SCHED __builtin_amdgcn_sched_barrier(0)
    Unit cur, nxt; int ui = 0;
    if (!S.next(0, cur)) return;
    f32x4 acc[2][2][4][2];
#pragma unroll
    for (int a = 0; a < 2; ++a)
#pragma unroll
        for (int b = 0; b < 2; ++b)
#pragma unroll
            for (int m = 0; m < 4; ++m)
#pragma unroll
                for (int n = 0; n < 2; ++n) acc[a][b][m][n] = (f32x4){0.f, 0.f, 0.f, 0.f};
    bf16x8 At[4][2], B0[2][2], B1[2][2];
    const char* cA = (const char*)g.A + (size_t)cur.pm * tstep; const char* cB = (const char*)g.Bt + (size_t)cur.pn * tstep;
    S.a_ready(cur);
    if constexpr (SP2) {
        PG8_STAGE(PG8_SB(0, 0), cB, voffB); PG8_STAGE(PG8_SB(0, 1), cB + hstep, voffB); PG8_STAGE(PG8_SA(0, 0), cA, voffA); PG8_STAGE(PG8_SA(0, 1), cA + hstep, voffA);
        if (wr == 1) PG8_BAR;
        PG8_WAIT_V(2); PG8_BAR;
        PG8_STAGE(PG8_SB(1, 0), cB + kstep, voffB); PG8_STAGE(PG8_SA(1, 0), cA + kstep, voffA); PG8_STAGE(PG8_SB(1, 1), cB + hstep + kstep, voffB);
        PG8_WAIT_V(6); PG8_BAR;
    } else {
        PG8_STAGE(PG8_SB(0, 0), cB, voffB); PG8_STAGE(PG8_SA(0, 0), cA, voffA); PG8_STAGE(PG8_SB(0, 1), cB + hstep, voffB); PG8_STAGE(PG8_SA(0, 1), cA + hstep, voffA);
        if (wr == 1) PG8_BAR;
        PG8_WAIT_V(4); PG8_BAR;
        PG8_STAGE(PG8_SB(1, 0), cB + kstep, voffB); PG8_STAGE(PG8_SA(1, 0), cA + kstep, voffA); PG8_STAGE(PG8_SB(1, 1), cB + hstep + kstep, voffB);
        PG8_WAIT_V(6); PG8_BAR;
    }
    for (;;) {
        const bool has_next = S.next(ui + 1, nxt);
        const char* nA = has_next ? (const char*)g.A + (size_t)nxt.pm * tstep : cA; const char* nB = has_next ? (const char*)g.Bt + (size_t)nxt.pn * tstep : cB;
        for (int t = 0; t < nt; t += 2) {
            const bool last = (t == nt - 2);
            const char* a1 = cA + (size_t)(t + 1) * kstep;
            const char* a2 = last ? nA : cA + (size_t)(t + 2) * kstep; const char* b2 = last ? nB : cB + (size_t)(t + 2) * kstep;
            const char* a3 = a2 + kstep; const char* b3 = b2 + kstep;
            if (last && has_next) S.a_ready(nxt);
            if constexpr (SP2) {
            PG8_LDB(B0, 0, 0); PG8_LDB(B1, 0, 1); PG8_SCHED; PG8_LDA(At, 0, 0); PG8_STAGE(PG8_SA(1, 1), a1 + hstep, voffA);
            PG8_WAIT_V(8); PG8_WAIT_L(0); PG8_BAR; PG8_MMA(0, 0, At, B0); PG8_MMA(0, 1, At, B1); PG8_BAR; PG8_SCHED;
            PG8_LDA(At, 0, 1); PG8_STAGE(PG8_SB(0, 0), b2, voffB); PG8_STAGE(PG8_SB(0, 1), b2 + hstep, voffB); PG8_STAGE(PG8_SA(0, 0), a2, voffA);
            PG8_WAIT_V(8); PG8_WAIT_L(0); PG8_BAR; PG8_MMA(1, 0, At, B0); PG8_MMA(1, 1, At, B1); PG8_BAR; PG8_SCHED;
            PG8_LDB(B0, 1, 0); PG8_LDB(B1, 1, 1); PG8_SCHED; PG8_LDA(At, 1, 0); PG8_STAGE(PG8_SA(0, 1), a2 + hstep, voffA);
            PG8_WAIT_V(8); PG8_WAIT_L(0); PG8_BAR; PG8_MMA(0, 0, At, B0); PG8_MMA(0, 1, At, B1); PG8_BAR; PG8_SCHED;
            PG8_LDA(At, 1, 1); PG8_STAGE(PG8_SB(1, 0), b3, voffB); PG8_STAGE(PG8_SB(1, 1), b3 + hstep, voffB); PG8_STAGE(PG8_SA(1, 0), a3, voffA);
            PG8_WAIT_V(8); PG8_WAIT_L(0); PG8_BAR; PG8_MMA(1, 0, At, B0); PG8_MMA(1, 1, At, B1); PG8_BAR; PG8_SCHED;
            } else {
            PG8_LDB(B0, 0, 0); PG8_SCHED; PG8_LDA(At, 0, 0); PG8_STAGE(PG8_SA(1, 1), a1 + hstep, voffA);
            PG8_WAIT_L(8); PG8_BAR; PG8_WAIT_L(0); PG8_MMA(0, 0, At, B0); PG8_BAR; PG8_SCHED;
            PG8_LDB(B1, 0, 1); PG8_STAGE(PG8_SB(0, 0), b2, voffB);
            PG8_BAR; PG8_WAIT_L(0); PG8_MMA(0, 1, At, B1); PG8_BAR;
            PG8_LDA(At, 0, 1); PG8_STAGE(PG8_SA(0, 0), a2, voffA);
            PG8_BAR; PG8_WAIT_L(0); PG8_MMA(1, 0, At, B0); PG8_BAR; PG8_SCHED;
            PG8_STAGE(PG8_SB(0, 1), b2 + hstep, voffB);
            PG8_WAIT_V(6); PG8_BAR; PG8_MMA(1, 1, At, B1); PG8_BAR;
            PG8_LDB(B0, 1, 0); PG8_SCHED; PG8_LDA(At, 1, 0); PG8_STAGE(PG8_SA(0, 1), a2 + hstep, voffA);
            PG8_WAIT_L(8); PG8_BAR; PG8_WAIT_L(0); PG8_MMA(0, 0, At, B0); PG8_BAR; PG8_SCHED;
            PG8_LDB(B1, 1, 1); PG8_STAGE(PG8_SB(1, 0), b3, voffB);
            PG8_BAR; PG8_WAIT_L(0); PG8_MMA(0, 1, At, B1); PG8_BAR;
            PG8_LDA(At, 1, 1); PG8_STAGE(PG8_SA(1, 0), a3, voffA);
            PG8_BAR; PG8_WAIT_L(0); PG8_MMA(1, 0, At, B0); PG8_BAR; PG8_SCHED;
            PG8_STAGE(PG8_SB(1, 1), b3 + hstep, voffB);
            PG8_WAIT_V(6); PG8_BAR; PG8_MMA(1, 1, At, B1); PG8_BAR;
            }
        }
        if constexpr (ALIGN_EPI) { if (wr == 0) PG8_BAR; }
        if constexpr (!Epi::AFTER_DRAIN) { E(acc, cur, wr, wc, fr, fq); S.done(cur); }
        if (!has_next) break;
#pragma unroll
        for (int a = 0; a < 2; ++a)
#pragma unroll
            for (int b = 0; b < 2; ++b)
#pragma unroll
                for (int m = 0; m < 4; ++m)
#pragma unroll
                    for (int n = 0; n < 2; ++n) acc[a][b][m][n] = (f32x4){0.f, 0.f, 0.f, 0.f};
        cur = nxt; cA = nA; cB = nB; ++ui;
        if constexpr (ALIGN_EPI) { if (wr == 1) PG8_BAR; }
    }
    PG8_WAIT_V(0);
    if constexpr (!ALIGN_EPI) { if (wr == 0) PG8_BAR; }
    PG8_BAR;
#undef PG8_SA
#undef PG8_SB
#undef PG8_STAGE
#undef PG8_LDA
#undef PG8_LDB
#undef PG8_MMA
#undef PG8_WAIT_V
#undef PG8_WAIT_L
#undef PG8_BAR
#undef PG8_SCHED
}
}

constexpr int NWAVES = 8;
constexpr int M = 16384, DM = 2048, DIN = 4352, DFF = 5632, HD = 64;
constexpr int QA_OFF = 0, KA_OFF = 1024, VA_OFF = 1152, QS_OFF = 1280, KS_OFF = 2304, VS_OFF = 3328;
constexpr float EPS = 1e-6f;

constexpr size_t MiB = 1u << 20;
constexpr size_t WS_CTL = 0, CTL_ZERO_BYTES = 64 * 1024;
constexpr size_t WS_RSTD1 = 1 * MiB;
constexpr size_t WS_SS2 = 2 * MiB, WS_SS3 = 4 * MiB;
constexpr size_t WS_WUP = 8 * MiB;
constexpr size_t WS_WDOWN = 52 * MiB;
constexpr size_t WS_XB = 74 * MiB;
constexpr size_t WS_GATE = 138 * MiB, WS_VAL = 314 * MiB;
constexpr size_t WS_WIN = 138 * MiB;
constexpr size_t WS_WOUT = 155 * MiB;
constexpr size_t WS_PROJ = 163 * MiB;
constexpr size_t WS_MIX = 299 * MiB;
constexpr size_t WS_YA = 363 * MiB, WS_YB = 427 * MiB;
constexpr size_t WS_END = 491 * MiB;
constexpr int CW_BAR = 4096;

constexpr int RING_BYTES = 131072, LDSCTL_OFF = RING_BYTES, MISC_OFF = LDSCTL_OFF + 320, LDS_BYTES = 147456;

#define GAS __attribute__((address_space(1)))
#define LAS __attribute__((address_space(3)))
typedef unsigned short bf16;
typedef unsigned v4u __attribute__((ext_vector_type(4)));
typedef float f32x4 __attribute__((ext_vector_type(4)));
#define LDS_WAIT() asm volatile("s_waitcnt lgkmcnt(0)" ::: "memory")
__device__ __forceinline__ unsigned f2bf(float f) { unsigned u = __builtin_bit_cast(unsigned, f); return (u + 0x7fffu + ((u >> 16) & 1u)) >> 16; }
__device__ __forceinline__ unsigned pk2(float lo, float hi) { return f2bf(lo) | (f2bf(hi) << 16); }
__device__ __forceinline__ float bf2f(unsigned h) { return __builtin_bit_cast(float, h << 16); }
__device__ __forceinline__ float wave_sum(float v) {
#pragma unroll
    for (int o = 1; o < 64; o <<= 1) v += __shfl_xor(v, o);
    return v;
}

#define XB_TMO      128
#define XB_XCNT(j)  (256  + 64 * (j))
#define XB_XSUB(j)  (1280 + 64 * (j))
#define XB_XGEN(j)  (2304 + 64 * (j))
#define XB_TOP      3328
#define XB_TOPGEN   3392
#define XCD_BAR_WORDS 3456
#define XB_SPIN_CAP (1u << 18)
__device__ __forceinline__ unsigned xb_ld(unsigned* p)              { return __hip_atomic_load(p, __ATOMIC_RELAXED, __HIP_MEMORY_SCOPE_AGENT); }
__device__ __forceinline__ unsigned xb_add(unsigned* p, unsigned v) { return __hip_atomic_fetch_add(p, v, __ATOMIC_RELAXED, __HIP_MEMORY_SCOPE_AGENT); }
__device__ __forceinline__ unsigned xb_xcc_id() { return (unsigned)__builtin_amdgcn_s_getreg((3 << 11) | 20) & 0xFu; }
#define XB_SPIN(cond, bar) do { unsigned _sp = 0; while (cond) { __builtin_amdgcn_s_sleep(1); \
    if ((++_sp & 255u) == 0u) { if (xb_ld(&(bar)[XB_TMO])) break; if (_sp > XB_SPIN_CAP) { atomicAdd(&(bar)[XB_TMO], 1u); break; } } } } while (0)
struct XcdBarrier { unsigned* bar; unsigned x; volatile LAS unsigned* st; };
__device__ __forceinline__ XcdBarrier xcd_barrier_post(unsigned* bar, volatile LAS unsigned* st) {
    XcdBarrier b; b.bar = bar; b.x = xb_xcc_id(); b.st = st;
    if (threadIdx.x == 0) (void)xb_add(&bar[XB_XCNT(b.x)], 1u);
    return b;
}
__device__ __forceinline__ void xcd_barrier_complete(unsigned* bar, unsigned x, unsigned& nloc, unsigned& nx) {
    const unsigned G = gridDim.x * gridDim.y * gridDim.z;
    unsigned sum, cnt, mine, sp = 0u;
    for (;;) {
        sum = 0u; cnt = 0u; mine = 0u;
#pragma unroll
        for (unsigned j = 0; j < 16; ++j) { const unsigned c = xb_ld(&bar[XB_XCNT(j)]); sum += c; cnt += (c > 0u) ? 1u : 0u; mine = (j == x) ? c : mine; }
        if (sum == G) break;
        __builtin_amdgcn_s_sleep(1);
        if ((++sp & 255u) == 0u) { if (xb_ld(&bar[XB_TMO])) break; if (sp > XB_SPIN_CAP) { atomicAdd(&bar[XB_TMO], 1u); break; } }
    }
    nloc = mine > 0u ? mine : 1u; nx = cnt > 0u ? cnt : 1u;
}
__device__ __forceinline__ void xcd_barrier(const XcdBarrier& b) {
    asm volatile("s_waitcnt vmcnt(0)" ::: "memory");
    __syncthreads();
    if (threadIdx.x == 0) {
        unsigned* bar = b.bar;
        __builtin_amdgcn_s_waitcnt(0);
        unsigned nloc = b.st[0], nx = b.st[1];
        if (nloc == 0u) { xcd_barrier_complete(bar, b.x, nloc, nx); b.st[0] = nloc; b.st[1] = nx; }
        const unsigned old = xb_add(&bar[XB_XSUB(b.x)], 1u);
        const unsigned gen = old / nloc;
        if (old + 1u == (gen + 1u) * nloc) {
            __builtin_amdgcn_fence(__ATOMIC_RELEASE, "agent");
            asm volatile("s_waitcnt vmcnt(0)" ::: "memory");
            const unsigned og = xb_add(&bar[XB_TOP], 1u);
            const unsigned tg = og / nx;
            if (og + 1u == (tg + 1u) * nx) xb_add(&bar[XB_TOPGEN], 1u);
            else XB_SPIN(xb_ld(&bar[XB_TOPGEN]) == tg, bar);
            __builtin_amdgcn_fence(__ATOMIC_ACQUIRE, "agent");
            xb_add(&bar[XB_XGEN(b.x)], 1u);
            asm volatile("s_waitcnt vmcnt(0)" ::: "memory");
        } else {
            XB_SPIN(xb_ld(&bar[XB_XGEN(b.x)]) == gen, bar);
            __builtin_amdgcn_fence(__ATOMIC_ACQUIRE, "agent");
            asm volatile("s_waitcnt vmcnt(0)" ::: "memory");
        }
    }
    __syncthreads();
}

__device__ const unsigned char kBucket[128] = {
    0, 1, 2, 3, 4, 5, 6, 7, 8, 9, 10, 11, 12, 13, 14, 15, 16, 16, 16, 17, 17, 18, 18, 18, 19, 19, 19, 20, 20, 20, 20, 21, 21, 21, 21, 22, 22, 22, 22, 22, 23, 23, 23, 23, 23, 23, 24, 24, 24, 24, 24, 24, 25, 25, 25, 25, 25, 25, 25, 26, 26, 26, 26, 26, 26, 26, 26, 27, 27, 27, 27, 27, 27, 27, 27, 27, 27, 28, 28, 28, 28, 28, 28, 28, 28, 28, 28, 29, 29, 29, 29, 29, 29, 29, 29, 29, 29, 29, 29, 30, 30, 30, 30, 30, 30, 30, 30, 30, 30, 30, 30, 30, 30, 31, 31, 31, 31, 31, 31, 31, 31, 31, 31, 31, 31, 31, 31, 31};

__device__ __forceinline__ void p0_transpose_item(const float* W, const float* gk, int K, int N, bf16* WT, LAS float* scr, int item, int lane) {
    const int nblk = N / 32, kb = item / nblk, nb = item % nblk, k0 = 64 * kb, n0 = 32 * nb;
#pragma unroll 8
    for (int i = 0; i < 32; ++i) { const int kk = 2 * i + (lane >> 5); float v = W[(size_t)(k0 + kk) * N + n0 + (lane & 31)]; if (gk) v *= gk[k0 + kk]; scr[kk * 33 + (lane & 31)] = v; }
    LDS_WAIT(); asm volatile("" ::: "memory");
    const int c = lane & 7;
#pragma unroll
    for (int j = 0; j < 4; ++j) { const int n = (lane >> 3) + 8 * j; const LAS float* s = scr + (8 * c) * 33 + n;
        v4u o; o.x = pk2(s[0 * 33], s[1 * 33]); o.y = pk2(s[2 * 33], s[3 * 33]); o.z = pk2(s[4 * 33], s[5 * 33]); o.w = pk2(s[6 * 33], s[7 * 33]);
        *(GAS v4u*)(WT + (size_t)(n0 + n) * K + k0 + 8 * c) = o; }
    LDS_WAIT(); asm volatile("" ::: "memory");
}
__device__ __forceinline__ void row_cvt(const float* xrow, bf16* orow, float* rstd, int lane) {
    const f32x4* xr = (const f32x4*)xrow + lane;
    f32x4 v[8]; float s = 0.f;
#pragma unroll
    for (int j = 0; j < 8; ++j) { v[j] = xr[64 * j]; s += (v[j].x * v[j].x + v[j].y * v[j].y) + (v[j].z * v[j].z + v[j].w * v[j].w); }
    s = wave_sum(s);
    if (lane == 0) *rstd = 1.0f / sqrtf(s * (1.0f / DM) + EPS);
    unsigned long long* o8 = (unsigned long long*)orow + lane;
#pragma unroll
    for (int j = 0; j < 8; ++j) o8[64 * j] = (unsigned long long)pk2(v[j].x, v[j].y) | ((unsigned long long)pk2(v[j].z, v[j].w) << 32);
}

__device__ __forceinline__ void load_row64(const bf16* p, float* d) {
#pragma unroll
    for (int c = 0; c < 8; ++c) { const v4u v = *(const v4u*)(p + c * 8);
        d[c * 8 + 0] = bf2f(v.x & 0xffffu); d[c * 8 + 1] = bf2f(v.x >> 16); d[c * 8 + 2] = bf2f(v.y & 0xffffu); d[c * 8 + 3] = bf2f(v.y >> 16);
        d[c * 8 + 4] = bf2f(v.z & 0xffffu); d[c * 8 + 5] = bf2f(v.z >> 16); d[c * 8 + 6] = bf2f(v.w & 0xffffu); d[c * 8 + 7] = bf2f(v.w >> 16); }
}
__device__ __forceinline__ float dot_row64(const bf16* p, const float* q) {
    float s = 0.f;
#pragma unroll
    for (int c = 0; c < 8; ++c) { const v4u v = *(const v4u*)(p + c * 8);
        s += q[c * 8 + 0] * bf2f(v.x & 0xffffu); s += q[c * 8 + 1] * bf2f(v.x >> 16); s += q[c * 8 + 2] * bf2f(v.y & 0xffffu); s += q[c * 8 + 3] * bf2f(v.y >> 16);
        s += q[c * 8 + 4] * bf2f(v.z & 0xffffu); s += q[c * 8 + 5] * bf2f(v.z >> 16); s += q[c * 8 + 6] * bf2f(v.w & 0xffffu); s += q[c * 8 + 7] * bf2f(v.w >> 16); }
    return s;
}
__device__ __forceinline__ void axpy_row64(const bf16* p, float a, float* o) {
#pragma unroll
    for (int c = 0; c < 8; ++c) { const v4u v = *(const v4u*)(p + c * 8);
        o[c * 8 + 0] += a * bf2f(v.x & 0xffffu); o[c * 8 + 1] += a * bf2f(v.x >> 16); o[c * 8 + 2] += a * bf2f(v.y & 0xffffu); o[c * 8 + 3] += a * bf2f(v.y >> 16);
        o[c * 8 + 4] += a * bf2f(v.z & 0xffffu); o[c * 8 + 5] += a * bf2f(v.z >> 16); o[c * 8 + 6] += a * bf2f(v.w & 0xffffu); o[c * 8 + 7] += a * bf2f(v.w >> 16); }
}
__device__ __forceinline__ void swa_item(const bf16* proj, const float* rel_bias, const float* sinks, float* ya, int t, int h) {
    const int kvh = h >> 3;
    float q[64], o[64];
    load_row64(proj + (size_t)t * DIN + QA_OFF + h * HD, q);
#pragma unroll
    for (int d = 0; d < 64; ++d) o[d] = 0.f;
    const float sink = sinks[h];
    float m = sink, l = 1.0f;
    const int j0 = t - 127 < 0 ? 0 : t - 127;
    for (int j = j0; j <= t; ++j) {
        const float s = dot_row64(proj + (size_t)j * DIN + KA_OFF + kvh * HD, q) * 0.125f + rel_bias[kBucket[t - j] * 16 + h];
        const float mn = fmaxf(m, s), f = expf(m - mn), p = expf(s - mn);
        l = l * f + p;
#pragma unroll
        for (int d = 0; d < 64; ++d) o[d] *= f;
        axpy_row64(proj + (size_t)j * DIN + VA_OFF + kvh * HD, p, o);
        m = mn;
    }
    const float inv = 1.0f / l;
    float* dst = ya + (size_t)t * 1024 + h * HD;
#pragma unroll
    for (int d = 0; d < 64; d += 4) *(f32x4*)(dst + d) = (f32x4){o[d] * inv, o[d + 1] * inv, o[d + 2] * inv, o[d + 3] * inv};
}
__device__ __forceinline__ float softplus_f(float z) { return fmaxf(z, 0.f) + log1pf(expf(-fabsf(z))); }
__device__ __forceinline__ void sb_item(const bf16* proj, float* yb, int t, int h) {
    float q[64], o[64];
    load_row64(proj + (size_t)t * DIN + QS_OFF + h * HD, q);
#pragma unroll
    for (int d = 0; d < 64; ++d) o[d] = 0.f;
    float run = 0.f;
    for (int s = t - 1; s >= 0 && run > -104.0f; --s) {
        const float z = dot_row64(proj + (size_t)s * DIN + KS_OFF + h * HD, q) * 0.125f;
        const float sp = softplus_f(z);
        const float a = expf((z - sp) + run);
        axpy_row64(proj + (size_t)s * DIN + VS_OFF + h * HD, a, o);
        run -= sp;
    }
    float* dst = yb + (size_t)t * 1024 + h * HD;
#pragma unroll
    for (int d = 0; d < 64; d += 4) *(f32x4*)(dst + d) = (f32x4){o[d], o[d + 1], o[d + 2], o[d + 3]};
}

struct Args { const float* in[14]; float* out; unsigned char* ws; };
__global__ void __launch_bounds__(NWAVES * 64, 2) mk_fwd(Args args) {
    extern __shared__ __attribute__((aligned(16))) unsigned char lds_raw[];
    LAS unsigned char* lds = (LAS unsigned char*)lds_raw;
    volatile LAS unsigned* MISC = (volatile LAS unsigned*)(lds + MISC_OFF);
    const int tid = threadIdx.x, lane = tid & 63, wave = __builtin_amdgcn_readfirstlane(tid >> 6);
    const int G = gridDim.x; const int bx = blockIdx.x; const int vcu = (G % 8 == 0) ? (bx % 8) * (G / 8) + bx / 8 : bx;
    unsigned char* ws = args.ws;
    unsigned* ctl = (unsigned*)(ws + WS_CTL);
    const float* x = args.in[0]; const float* w_in = args.in[1]; const float* g_attn = args.in[2]; const float* rel_bias = args.in[3];
    const float* sinks = args.in[4]; const float* g_swa = args.in[5]; const float* g_sb = args.in[6]; const float* w_out = args.in[7];
    const float* g_mlp = args.in[8]; const float* w_up = args.in[9]; const float* w_conv = args.in[10]; const float* b_conv = args.in[11];
    const float* w_down = args.in[12]; const float* g_final = args.in[13];
    float* out = args.out;
    float* rstd1 = (float*)(ws + WS_RSTD1); float* ss2 = (float*)(ws + WS_SS2); float* ss3 = (float*)(ws + WS_SS3);
    bf16* WinT = (bf16*)(ws + WS_WIN); bf16* WoutT = (bf16*)(ws + WS_WOUT); bf16* WupT = (bf16*)(ws + WS_WUP); bf16* WdownT = (bf16*)(ws + WS_WDOWN);
    bf16* xb = (bf16*)(ws + WS_XB); bf16* proj = (bf16*)(ws + WS_PROJ); bf16* mix = (bf16*)(ws + WS_MIX);
    float* ya = (float*)(ws + WS_YA); float* yb = (float*)(ws + WS_YB);
    bf16* gate = (bf16*)(ws + WS_GATE); bf16* val = (bf16*)(ws + WS_VAL);

    for (int u = tid; u < (LDS_BYTES - LDSCTL_OFF) / 4; u += NWAVES * 64) ((LAS unsigned*)(lds + LDSCTL_OFF))[u] = 0u;
    __syncthreads();
    XcdBarrier bar = xcd_barrier_post(ctl + CW_BAR, MISC + 8);
    const int gw = vcu * NWAVES + wave, NGW = G * NWAVES;
    const int gt = vcu * (NWAVES * 64) + tid, NGT = G * NWAVES * 64;

    {
        LAS float* scr = (LAS float*)(lds + wave * 16384);
        constexpr int I_IN = (DM / 64) * (DIN / 32), I_OUT = (DM / 64) * (DM / 32), I_UP = (DM / 64) * (2 * DFF / 32), I_DOWN = (DFF / 64) * (DM / 32);
        constexpr int NITEMS = I_IN + I_OUT + I_UP + I_DOWN;
        for (int it = gw; it < NITEMS; it += NGW) {
            int r = it;
            if (r < I_IN) { p0_transpose_item(w_in, g_attn, DM, DIN, WinT, scr, r, lane); continue; } r -= I_IN;
            if (r < I_OUT) { p0_transpose_item(w_out, nullptr, DM, DM, WoutT, scr, r, lane); continue; } r -= I_OUT;
            if (r < I_UP) { p0_transpose_item(w_up, g_mlp, DM, 2 * DFF, WupT, scr, r, lane); continue; } r -= I_UP;
            p0_transpose_item(w_down, nullptr, DFF, DM, WdownT, scr, r, lane);
        }
        for (int m = gw; m < M; m += NGW) row_cvt(x + (size_t)m * DM, xb + (size_t)m * DM, rstd1 + m, lane);
    }
    xcd_barrier(bar);

    {
        pg8::Gemm g{xb, WinT, M, DIN, DM}; pg8::StaticOrder S; S.init(M, DIN, G, bx);
        pg8::EpiRowScaleBf16 E{proj, proj, DIN, 1 << 30, rstd1, nullptr};
        pg8::gemm_phase<pg8::EpiRowScaleBf16, pg8::StaticOrder, true, true>(lds, g, S, E);
    }
    xcd_barrier(bar);

    for (int i = gt; i < 16 * M; i += NGT) swa_item(proj, rel_bias, sinks, ya, i % M, i / M);
    for (int i = gt; i < 16 * M; i += NGT) sb_item(proj, yb, i % M, i / M);
    xcd_barrier(bar);

    for (int m = gw; m < M; m += NGW) {
#pragma unroll
        for (int grp = 0; grp < 2; ++grp) {
            const f32x4* yr = (const f32x4*)((grp ? yb : ya) + (size_t)m * 1024) + lane; const f32x4* gr = (const f32x4*)(grp ? g_sb : g_swa) + lane;
            f32x4 v[4]; float s = 0.f;
#pragma unroll
            for (int j = 0; j < 4; ++j) { v[j] = yr[64 * j]; s += (v[j].x * v[j].x + v[j].y * v[j].y) + (v[j].z * v[j].z + v[j].w * v[j].w); }
            s = wave_sum(s);
            const float r = 1.0f / sqrtf(s * (1.0f / 1024) + EPS);
            unsigned long long* o8 = (unsigned long long*)(mix + (size_t)m * DM + grp * 1024) + lane;
#pragma unroll
            for (int j = 0; j < 4; ++j) { const f32x4 gg = gr[64 * j]; const f32x4 u = v[j] * r * gg; o8[64 * j] = (unsigned long long)pk2(u.x, u.y) | ((unsigned long long)pk2(u.z, u.w) << 32); }
        }
    }
    xcd_barrier(bar);

    {
        pg8::Gemm g{mix, WoutT, M, DM, DM}; pg8::StaticOrder S; S.init(M, DM, G, bx);
        pg8::EpiResidual E{x, out, xb, DM, ss2};
        pg8::gemm_phase<pg8::EpiResidual, pg8::StaticOrder, true, true>(lds, g, S, E);
    }
    xcd_barrier(bar);

    {
        pg8::Gemm g{xb, WupT, M, 2 * DFF, DM}; pg8::StaticOrder S; S.init(M, 2 * DFF, G, bx);
        pg8::EpiRowScaleBf16 E{gate, val, DFF, DFF / 256, nullptr, ss2};
        pg8::gemm_phase<pg8::EpiRowScaleBf16, pg8::StaticOrder, true, true>(lds, g, S, E);
    }
    xcd_barrier(bar);

    for (size_t i = gt; i < (size_t)M * (DFF / 8); i += NGT) {
        const int t = (int)(i / (DFF / 8)), c = (int)(i % (DFF / 8)) * 8; const size_t idx = (size_t)t * DFF + c;
        const v4u g2 = *(const v4u*)(gate + idx), vv = *(const v4u*)(val + idx);
        v4u g1 = (v4u){0u, 0u, 0u, 0u}, g0 = (v4u){0u, 0u, 0u, 0u};
        if (t >= 1) g1 = *(const v4u*)(gate + idx - DFF);
        if (t >= 2) g0 = *(const v4u*)(gate + idx - 2 * DFF);
        float r[8];
#pragma unroll
        for (int e = 0; e < 8; ++e) {
            const unsigned w2 = g2[e >> 1], w1 = g1[e >> 1], w0 = g0[e >> 1], wv = vv[e >> 1];
            const float a2 = (e & 1) ? bf2f(w2 >> 16) : bf2f(w2 & 0xffffu), a1 = (e & 1) ? bf2f(w1 >> 16) : bf2f(w1 & 0xffffu), a0 = (e & 1) ? bf2f(w0 >> 16) : bf2f(w0 & 0xffffu);
            const float v = (e & 1) ? bf2f(wv >> 16) : bf2f(wv & 0xffffu);
            const float gc = b_conv[c + e] + a0 * w_conv[c + e] + a1 * w_conv[DFF + c + e] + a2 * w_conv[2 * DFF + c + e];
            r[e] = gc / (1.0f + expf(-gc)) * v;
        }
        v4u o; o.x = pk2(r[0], r[1]); o.y = pk2(r[2], r[3]); o.z = pk2(r[4], r[5]); o.w = pk2(r[6], r[7]);
        *(v4u*)(val + idx) = o;
    }
    xcd_barrier(bar);

    {
        pg8::Gemm g{val, WdownT, M, DM, DFF}; pg8::StaticOrder S; S.init(M, DM, G, bx);
        pg8::EpiResidual E{out, out, nullptr, DM, ss3};
        pg8::gemm_phase<pg8::EpiResidual, pg8::StaticOrder, true, true>(lds, g, S, E);
    }
    xcd_barrier(bar);

    {
        const unsigned tmo = xb_ld(ctl + CW_BAR + XB_TMO);
        for (int m = gw; m < M; m += NGW) {
            float s = (lane < 32) ? ss3[(size_t)m * 32 + lane] : 0.f; s = wave_sum(s);
            float r = 1.0f / sqrtf(s * (1.0f / DM) + EPS);
            if (tmo) r = __builtin_nanf("");
            f32x4* xr = (f32x4*)(out + (size_t)m * DM) + lane; const f32x4* gr = (const f32x4*)g_final + lane;
#pragma unroll
            for (int j = 0; j < 8; ++j) { const f32x4 v = xr[64 * j]; xr[64 * j] = v * r * gr[64 * j]; }
        }
    }
}

extern "C" void kernel_launch(void* const* d_in, const int* in_sizes, int n_in, void* d_out, int out_size, void* d_ws, size_t ws_size, hipStream_t stream) {
    static int grid = 0;
    if (grid == 0) {
        if (n_in != 14 || out_size != M * DM || ws_size < WS_END) { fprintf(stderr, "kernel_launch: unexpected shapes (n_in %d out %d ws %zu)\n", n_in, out_size, ws_size); grid = -1; return; }
        int dev = 0, cus = 0, per_cu = 0;
        if (hipGetDevice(&dev) != hipSuccess || hipDeviceGetAttribute(&cus, hipDeviceAttributeMultiprocessorCount, dev) != hipSuccess) { grid = -1; return; }
        if (hipFuncSetAttribute((const void*)mk_fwd, hipFuncAttributeMaxDynamicSharedMemorySize, LDS_BYTES) != hipSuccess) { fprintf(stderr, "kernel_launch: hipFuncSetAttribute failed\n"); grid = -1; return; }
        if (hipOccupancyMaxActiveBlocksPerMultiprocessor(&per_cu, (const void*)mk_fwd, NWAVES * 64, LDS_BYTES) != hipSuccess || per_cu < 1) { fprintf(stderr, "kernel_launch: occupancy query reports %d\n", per_cu); }
        (void)hipGetLastError();
        grid = cus;
    }
    if (grid < 0) return;
    if (hipMemsetAsync((char*)d_ws + WS_CTL, 0, CTL_ZERO_BYTES, stream) != hipSuccess) return;
    Args a{};
    for (int i = 0; i < 14; ++i) a.in[i] = (const float*)d_in[i];
    a.out = (float*)d_out; a.ws = (unsigned char*)d_ws;
    hipLaunchKernelGGL(mk_fwd, dim3(grid), dim3(NWAVES * 64), LDS_BYTES, stream, a);
}
```

```cpp
#include <hip/hip_runtime.h>
#include <cstdint>
#include <cstdio>

namespace pg8 {
#define PG8_LAS __attribute__((address_space(3)))
#define PG8_GAS __attribute__((address_space(1)))
typedef unsigned short bf16_t;
typedef short bf16x8 __attribute__((ext_vector_type(8)));
typedef float f32x4 __attribute__((ext_vector_type(4)));
typedef unsigned u32x4 __attribute__((ext_vector_type(4)));
typedef unsigned u32x2 __attribute__((ext_vector_type(2)));
constexpr int BM = 256, BK = 64, HALF = 128, HTB = HALF * BK * 2  , STAGE_BYTES = 8 * HTB, NXCD = 8, WGM = 8;

__host__ __device__ __forceinline__ int lds_byte(int r, int c) { const int st = (r >> 4) * 2 + (c >> 5), rr = r & 15, cc = c & 31, ob = rr * 64 + cc * 2; return st * 1024 + (ob ^ (((ob >> 9) & 1) << 5)); }
__host__ __device__ __forceinline__ void stage_rc(int b, int& R, int& C) { const int st = b / 1024, sb = b % 1024, swz = sb ^ (((sb >> 9) & 1) << 5); R = (st >> 1) * 16 + swz / 64; C = (st & 1) * 32 + (swz % 64) / 2; }
__host__ __device__ __forceinline__ int perm32(int rho) { const int n = rho >> 4, i = rho & 15; return 8 * (i >> 2) + 4 * n + (i & 3); }

struct Unit { int pm, pn; };
struct Gemm { const bf16_t* A; const bf16_t* Bt; int M, N, K; };

struct StaticOrder {
    int nM, nN, nwg, G, c;
    __host__ __device__ void init(int M, int N, int G_, int c_) { nM = M / BM; nN = N / BM; nwg = nM * nN; G = G_; c = c_; }
    __host__ __device__ bool next(int i, Unit& u) const {
        const long L = (long)i * G + c; if (L >= nwg) return false;
        int wgid = (int)L; { const int q = nwg / NXCD, r = nwg % NXCD, xcd = wgid % NXCD, off = wgid / NXCD; wgid = (xcd < r ? xcd * (q + 1) : r * (q + 1) + (xcd - r) * q) + off; }
        const int nig = WGM * nN, gid = wgid / nig, fm = gid * WGM, gsz = (nM - fm) < WGM ? (nM - fm) : WGM;
        u.pm = fm + ((wgid % nig) % gsz); u.pn = (wgid % nig) / gsz; return true;
    }
    __device__ __forceinline__ void a_ready(const Unit&) const {}
    __device__ __forceinline__ void done(const Unit&) const {}
};

__device__ __forceinline__ unsigned cvt_pk_bf16(float lo, float hi) { unsigned r; asm volatile("v_cvt_pk_bf16_f32 %0, %1, %2" : "=v"(r) : "v"(lo), "v"(hi)); return r; }

struct EpiRowScaleBf16 {
    static constexpr bool PERM = true, AFTER_DRAIN = false;
    bf16_t* O; bf16_t* O2; int ldc; int split_pn; const float* rs; const float* slots;
    __device__ __forceinline__ void operator()(const f32x4 (&acc)[2][2][4][2], const Unit& u, int wr, int wc, int fr, int fq) const {
        const int row0 = u.pm * BM + wr * 64 + fr; int pn = u.pn; bf16_t* base = O;
        if (pn >= split_pn) { pn -= split_pn; base = O2; }
        const int col0 = pn * BM + wc * 32 + 8 * fq;
        float sc[2][4];
#pragma unroll
        for (int ai = 0; ai < 2; ++ai)
#pragma unroll
            for (int m = 0; m < 4; ++m) {
                const int r = row0 + ai * HALF + m * 16;
                if (rs) sc[ai][m] = *(const PG8_GAS float*)(rs + r);
                else { const PG8_GAS f32x4* sp = (const PG8_GAS f32x4*)(slots + (size_t)r * 32 + fq * 8); const f32x4 a = sp[0], b = sp[1];
                    float s = ((a[0] + a[1]) + (a[2] + a[3])) + ((b[0] + b[1]) + (b[2] + b[3])); s += __shfl_xor(s, 16); s += __shfl_xor(s, 32);
                    sc[ai][m] = 1.0f / sqrtf(s * (1.0f / 2048.0f) + 1e-6f); }
            }
#pragma unroll
        for (int ai = 0; ai < 2; ++ai)
#pragma unroll
            for (int m = 0; m < 4; ++m) { bf16_t* rowp = base + (size_t)(row0 + ai * HALF + m * 16) * ldc + col0; const float s = sc[ai][m];
#pragma unroll
                for (int bj = 0; bj < 2; ++bj) { const f32x4 v0 = acc[ai][bj][m][0] * s, v1 = acc[ai][bj][m][1] * s;
                    u32x4 w; w.x = cvt_pk_bf16(v0[0], v0[1]); w.y = cvt_pk_bf16(v0[2], v0[3]); w.z = cvt_pk_bf16(v1[0], v1[1]); w.w = cvt_pk_bf16(v1[2], v1[3]);
                    *(u32x4*)(rowp + bj * HALF) = w; } }
    }
};
struct EpiResidual {
    static constexpr bool PERM = false, AFTER_DRAIN = false;
    const float* base; float* out; bf16_t* ob; int ldc; float* slots;
    __device__ __forceinline__ void operator()(const f32x4 (&acc)[2][2][4][2], const Unit& u, int wr, int wc, int fr, int fq) const {
        const int row0 = u.pm * BM + wr * 64 + fr, col0 = u.pn * BM + wc * 32 + 4 * fq;
#pragma unroll
        for (int ai = 0; ai < 2; ++ai)
#pragma unroll
            for (int m = 0; m < 4; ++m) { const int r = row0 + ai * HALF + m * 16; const size_t off = (size_t)r * ldc + col0; float ss = 0.f;
#pragma unroll
                for (int bj = 0; bj < 2; ++bj)
#pragma unroll
                    for (int n = 0; n < 2; ++n) { const f32x4 v = *(const f32x4*)(base + off + bj * HALF + n * 16) + acc[ai][bj][m][n];
                        *(f32x4*)(out + off + bj * HALF + n * 16) = v; ss += (v[0] * v[0] + v[1] * v[1]) + (v[2] * v[2] + v[3] * v[3]);
                        if (ob) { u32x2 w; w.x = cvt_pk_bf16(v[0], v[1]); w.y = cvt_pk_bf16(v[2], v[3]); *(u32x2*)(ob + off + bj * HALF + n * 16) = w; } }
                ss += __shfl_xor(ss, 16); ss += __shfl_xor(ss, 32);
                if (fq == 0) slots[(size_t)r * 32 + u.pn * 4 + wc] = ss; }
    }
};

template <class Epi, class Sched, bool ALIGN_EPI = false, bool SP2 = false>
__device__ __forceinline__ void gemm_phase(PG8_LAS unsigned char* lds, const Gemm g, const Sched& S, const Epi& E) {
    int tid = threadIdx.x; asm volatile("" : "+v"(tid));
    const int wid = __builtin_amdgcn_readfirstlane(tid >> 6), lane = tid & 63, wr = wid >> 2, wc = wid & 3, fr = lane & 15, fq = lane >> 4;
    const int K = g.K, nt = K / BK;
    unsigned voffA[2], voffB[2];
#pragma unroll
    for (int i = 0; i < 2; ++i) { int R, C; stage_rc(tid * 16 + i * 8192, R, C); const int Rb = Epi::PERM ? ((R & ~31) + perm32(R & 31)) : R;
        voffA[i] = (unsigned)(R * K + C) * 2u; voffB[i] = (unsigned)(Rb * K + C) * 2u; }
    const size_t kstep = (size_t)(BK * 2);
    const size_t hstep = (size_t)HALF * K * 2;
    const size_t tstep = 2 * hstep;
    const unsigned ldsw = (unsigned)wid * 1024u;
    const int aoff = lds_byte(wr * 64 + fr, fq * 8), boff = lds_byte(wc * 32 + fr, fq * 8);
#define PG8_SA(b, h) (((b) * 2 + (h)) * HTB)
#define PG8_SB(b, h) ((4 + (b) * 2 + (h)) * HTB)
#define PG8_STAGE(bufoff, gbase, voff) do { _Pragma("unroll") for (int _i = 0; _i < 2; ++_i) \
        __builtin_amdgcn_global_load_lds((const unsigned*)((const char*)(gbase) + (voff)[_i]), (PG8_LAS unsigned*)(lds + (bufoff) + ldsw + _i * 8192), 16, 0, 0); } while (0)
#define PG8_LDA(dst, b, h) do { _Pragma("unroll") for (int m = 0; m < 4; ++m) _Pragma("unroll") for (int k = 0; k < 2; ++k) dst[m][k] = *(const PG8_LAS bf16x8*)(lds + PG8_SA(b, h) + aoff + m * 2048 + k * 1024); } while (0)
#define PG8_LDB(dst, b, h) do { _Pragma("unroll") for (int n = 0; n < 2; ++n) _Pragma("unroll") for (int k = 0; k < 2; ++k) dst[n][k] = *(const PG8_LAS bf16x8*)(lds + PG8_SB(b, h) + boff + n * 2048 + k * 1024); } while (0)
#define PG8_MMA(ai, bj, At, Bt) do { __builtin_amdgcn_s_setprio(1); _Pragma("unroll") for (int m = 0; m < 4; ++m) _Pragma("unroll") for (int n = 0; n < 2; ++n) _Pragma("unroll") for (int k = 0; k < 2; ++k) \
        acc[ai][bj][m][n] = __builtin_amdgcn_mfma_f32_16x16x32_bf16(Bt[n][k], At[m][k], acc[ai][bj][m][n], 0, 0, 0); __builtin_amdgcn_s_setprio(0); } while (0)
#define PG8_WAIT_V(n) asm volatile("s_waitcnt vmcnt(" #n ")" ::: "memory")
#define PG8_WAIT_L(n) asm volatile("s_waitcnt lgkmcnt(" #n ")" ::: "memory")
#define PG8_BAR __builtin_amdgcn_s_barrier()
#define PG8_SCHED __builtin_amdgcn_sched_barrier(0)
    Unit cur, nxt; int ui = 0;
    if (!S.next(0, cur)) return;
    f32x4 acc[2][2][4][2];
#pragma unroll
    for (int a = 0; a < 2; ++a)
#pragma unroll
        for (int b = 0; b < 2; ++b)
#pragma unroll
            for (int m = 0; m < 4; ++m)
#pragma unroll
                for (int n = 0; n < 2; ++n) acc[a][b][m][n] = (f32x4){0.f, 0.f, 0.f, 0.f};
    bf16x8 At[4][2], B0[2][2], B1[2][2];
    const char* cA = (const char*)g.A + (size_t)cur.pm * tstep; const char* cB = (const char*)g.Bt + (size_t)cur.pn * tstep;
    S.a_ready(cur);
    if constexpr (SP2) {
        PG8_STAGE(PG8_SB(0, 0), cB, voffB); PG8_STAGE(PG8_SB(0, 1), cB + hstep, voffB); PG8_STAGE(PG8_SA(0, 0), cA, voffA); PG8_STAGE(PG8_SA(0, 1), cA + hstep, voffA);
        if (wr == 1) PG8_BAR;
        PG8_WAIT_V(2); PG8_BAR;
        PG8_STAGE(PG8_SB(1, 0), cB + kstep, voffB); PG8_STAGE(PG8_SA(1, 0), cA + kstep, voffA); PG8_STAGE(PG8_SB(1, 1), cB + hstep + kstep, voffB);
        PG8_WAIT_V(6); PG8_BAR;
    } else {
        PG8_STAGE(PG8_SB(0, 0), cB, voffB); PG8_STAGE(PG8_SA(0, 0), cA, voffA); PG8_STAGE(PG8_SB(0, 1), cB + hstep, voffB); PG8_STAGE(PG8_SA(0, 1), cA + hstep, voffA);
        if (wr == 1) PG8_BAR;
        PG8_WAIT_V(4); PG8_BAR;
        PG8_STAGE(PG8_SB(1, 0), cB + kstep, voffB); PG8_STAGE(PG8_SA(1, 0), cA + kstep, voffA); PG8_STAGE(PG8_SB(1, 1), cB + hstep + kstep, voffB);
        PG8_WAIT_V(6); PG8_BAR;
    }
    for (;;) {
        const bool has_next = S.next(ui + 1, nxt);
        const char* nA = has_next ? (const char*)g.A + (size_t)nxt.pm * tstep : cA; const char* nB = has_next ? (const char*)g.Bt + (size_t)nxt.pn * tstep : cB;
        for (int t = 0; t < nt; t += 2) {
            const bool last = (t == nt - 2);
            const char* a1 = cA + (size_t)(t + 1) * kstep;
            const char* a2 = last ? nA : cA + (size_t)(t + 2) * kstep; const char* b2 = last ? nB : cB + (size_t)(t + 2) * kstep;
            const char* a3 = a2 + kstep; const char* b3 = b2 + kstep;
            if (last && has_next) S.a_ready(nxt);
            if constexpr (SP2) {
            PG8_LDB(B0, 0, 0); PG8_LDB(B1, 0, 1); PG8_SCHED; PG8_LDA(At, 0, 0); PG8_STAGE(PG8_SA(1, 1), a1 + hstep, voffA);
            PG8_WAIT_V(8); PG8_WAIT_L(0); PG8_BAR; PG8_MMA(0, 0, At, B0); PG8_MMA(0, 1, At, B1); PG8_BAR; PG8_SCHED;
            PG8_LDA(At, 0, 1); PG8_STAGE(PG8_SB(0, 0), b2, voffB); PG8_STAGE(PG8_SB(0, 1), b2 + hstep, voffB); PG8_STAGE(PG8_SA(0, 0), a2, voffA);
            PG8_WAIT_V(8); PG8_WAIT_L(0); PG8_BAR; PG8_MMA(1, 0, At, B0); PG8_MMA(1, 1, At, B1); PG8_BAR; PG8_SCHED;
            PG8_LDB(B0, 1, 0); PG8_LDB(B1, 1, 1); PG8_SCHED; PG8_LDA(At, 1, 0); PG8_STAGE(PG8_SA(0, 1), a2 + hstep, voffA);
            PG8_WAIT_V(8); PG8_WAIT_L(0); PG8_BAR; PG8_MMA(0, 0, At, B0); PG8_MMA(0, 1, At, B1); PG8_BAR; PG8_SCHED;
            PG8_LDA(At, 1, 1); PG8_STAGE(PG8_SB(1, 0), b3, voffB); PG8_STAGE(PG8_SB(1, 1), b3 + hstep, voffB); PG8_STAGE(PG8_SA(1, 0), a3, voffA);
            PG8_WAIT_V(8); PG8_WAIT_L(0); PG8_BAR; PG8_MMA(1, 0, At, B0); PG8_MMA(1, 1, At, B1); PG8_BAR; PG8_SCHED;
            } else {
            PG8_LDB(B0, 0, 0); PG8_SCHED; PG8_LDA(At, 0, 0); PG8_STAGE(PG8_SA(1, 1), a1 + hstep, voffA);
            PG8_WAIT_L(8); PG8_BAR; PG8_WAIT_L(0); PG8_MMA(0, 0, At, B0); PG8_BAR; PG8_SCHED;
            PG8_LDB(B1, 0, 1); PG8_STAGE(PG8_SB(0, 0), b2, voffB);
            PG8_BAR; PG8_WAIT_L(0); PG8_MMA(0, 1, At, B1); PG8_BAR;
            PG8_LDA(At, 0, 1); PG8_STAGE(PG8_SA(0, 0), a2, voffA);
            PG8_BAR; PG8_WAIT_L(0); PG8_MMA(1, 0, At, B0); PG8_BAR; PG8_SCHED;
            PG8_STAGE(PG8_SB(0, 1), b2 + hstep, voffB);
            PG8_WAIT_V(6); PG8_BAR; PG8_MMA(1, 1, At, B1); PG8_BAR;
            PG8_LDB(B0, 1, 0); PG8_SCHED; PG8_LDA(At, 1, 0); PG8_STAGE(PG8_SA(0, 1), a2 + hstep, voffA);
            PG8_WAIT_L(8); PG8_BAR; PG8_WAIT_L(0); PG8_MMA(0, 0, At, B0); PG8_BAR; PG8_SCHED;
            PG8_LDB(B1, 1, 1); PG8_STAGE(PG8_SB(1, 0), b3, voffB);
            PG8_BAR; PG8_WAIT_L(0); PG8_MMA(0, 1, At, B1); PG8_BAR;
            PG8_LDA(At, 1, 1); PG8_STAGE(PG8_SA(1, 0), a3, voffA);
            PG8_BAR; PG8_WAIT_L(0); PG8_MMA(1, 0, At, B0); PG8_BAR; PG8_SCHED;
            PG8_STAGE(PG8_SB(1, 1), b3 + hstep, voffB);
            PG8_WAIT_V(6); PG8_BAR; PG8_MMA(1, 1, At, B1); PG8_BAR;
            }
        }
        if constexpr (ALIGN_EPI) { if (wr == 0) PG8_BAR; }
        if constexpr (!Epi::AFTER_DRAIN) { E(acc, cur, wr, wc, fr, fq); S.done(cur); }
        if (!has_next) break;
#pragma unroll
        for (int a = 0; a < 2; ++a)
#pragma unroll
            for (int b = 0; b < 2; ++b)
#pragma unroll
                for (int m = 0; m < 4; ++m)
#pragma unroll
                    for (int n = 0; n < 2; ++n) acc[a][b][m][n] = (f32x4){0.f, 0.f, 0.f, 0.f};
        cur = nxt; cA = nA; cB = nB; ++ui;
        if constexpr (ALIGN_EPI) { if (wr == 1) PG8_BAR; }
    }
    PG8_WAIT_V(0);
    if constexpr (!ALIGN_EPI) { if (wr == 0) PG8_BAR; }
    PG8_BAR;
#undef PG8_SA
#undef PG8_SB
#undef PG8_STAGE
#undef PG8_LDA
#undef PG8_LDB
#undef PG8_MMA
#undef PG8_WAIT_V
#undef PG8_WAIT_L
#undef PG8_BAR
#undef PG8_SCHED
}
}

constexpr int NWAVES = 8;
constexpr int M = 16384, DM = 2048, DIN = 4352, DFF = 5632, HD = 64;
constexpr int QA_OFF = 0, KA_OFF = 1024, VA_OFF = 1152, QS_OFF = 1280, KS_OFF = 2304, VS_OFF = 3328;
constexpr float EPS = 1e-6f;

constexpr size_t MiB = 1u << 20;
constexpr size_t WS_CTL = 0, CTL_ZERO_BYTES = 64 * 1024;
constexpr size_t WS_RSTD1 = 1 * MiB;
constexpr size_t WS_SS2 = 2 * MiB, WS_SS3 = 4 * MiB, WS_SSY = 6 * MiB;
constexpr size_t WS_WUP = 8 * MiB;
constexpr size_t WS_WDOWN = 52 * MiB;
constexpr size_t WS_XB = 74 * MiB;
constexpr size_t WS_GATE = 138 * MiB, WS_VAL = 314 * MiB;
constexpr size_t WS_WIN = 138 * MiB;
constexpr size_t WS_WOUT = 155 * MiB;
constexpr size_t WS_PROJ = 163 * MiB;
constexpr size_t WS_MIX = 299 * MiB;
constexpr size_t WS_YA = 363 * MiB, WS_YB = 427 * MiB;
constexpr size_t WS_END = 491 * MiB;
constexpr int CW_BAR = 4096;

constexpr int RING_BYTES = 131072, ATT_TAB_OFF = RING_BYTES  , ATT_WSF_OFF = ATT_TAB_OFF + 16384  , LDSCTL_OFF = ATT_WSF_OFF + 2048, MISC_OFF = LDSCTL_OFF + 320, LDS_BYTES = 155648;

#define GAS __attribute__((address_space(1)))
#define LAS __attribute__((address_space(3)))
typedef unsigned short bf16;
typedef unsigned v4u __attribute__((ext_vector_type(4)));
typedef float f32x4 __attribute__((ext_vector_type(4)));
#define LDS_WAIT() asm volatile("s_waitcnt lgkmcnt(0)" ::: "memory")
__device__ __forceinline__ unsigned f2bf(float f) { unsigned u = __builtin_bit_cast(unsigned, f); return (u + 0x7fffu + ((u >> 16) & 1u)) >> 16; }
__device__ __forceinline__ unsigned pk2(float lo, float hi) { return f2bf(lo) | (f2bf(hi) << 16); }
__device__ __forceinline__ float bf2f(unsigned h) { return __builtin_bit_cast(float, h << 16); }
__device__ __forceinline__ float wave_sum(float v) {
#pragma unroll
    for (int o = 1; o < 64; o <<= 1) v += __shfl_xor(v, o);
    return v;
}

#define XB_TMO      128
#define XB_XCNT(j)  (256  + 64 * (j))
#define XB_XSUB(j)  (1280 + 64 * (j))
#define XB_XGEN(j)  (2304 + 64 * (j))
#define XB_TOP      3328
#define XB_TOPGEN   3392
#define XCD_BAR_WORDS 3456
#define XB_SPIN_CAP (1u << 18)
__device__ __forceinline__ unsigned xb_ld(unsigned* p)              { return __hip_atomic_load(p, __ATOMIC_RELAXED, __HIP_MEMORY_SCOPE_AGENT); }
__device__ __forceinline__ unsigned xb_add(unsigned* p, unsigned v) { return __hip_atomic_fetch_add(p, v, __ATOMIC_RELAXED, __HIP_MEMORY_SCOPE_AGENT); }
__device__ __forceinline__ unsigned xb_xcc_id() { return (unsigned)__builtin_amdgcn_s_getreg((3 << 11) | 20) & 0xFu; }
#define XB_SPIN(cond, bar) do { unsigned _sp = 0; while (cond) { __builtin_amdgcn_s_sleep(1); \
    if ((++_sp & 255u) == 0u) { if (xb_ld(&(bar)[XB_TMO])) break; if (_sp > XB_SPIN_CAP) { atomicAdd(&(bar)[XB_TMO], 1u); break; } } } } while (0)
struct XcdBarrier { unsigned* bar; unsigned x; volatile LAS unsigned* st; };
__device__ __forceinline__ XcdBarrier xcd_barrier_post(unsigned* bar, volatile LAS unsigned* st) {
    XcdBarrier b; b.bar = bar; b.x = xb_xcc_id(); b.st = st;
    if (threadIdx.x == 0) (void)xb_add(&bar[XB_XCNT(b.x)], 1u);
    return b;
}
__device__ __forceinline__ void xcd_barrier_complete(unsigned* bar, unsigned x, unsigned& nloc, unsigned& nx) {
    const unsigned G = gridDim.x * gridDim.y * gridDim.z;
    unsigned sum, cnt, mine, sp = 0u;
    for (;;) {
        sum = 0u; cnt = 0u; mine = 0u;
#pragma unroll
        for (unsigned j = 0; j < 16; ++j) { const unsigned c = xb_ld(&bar[XB_XCNT(j)]); sum += c; cnt += (c > 0u) ? 1u : 0u; mine = (j == x) ? c : mine; }
        if (sum == G) break;
        __builtin_amdgcn_s_sleep(1);
        if ((++sp & 255u) == 0u) { if (xb_ld(&bar[XB_TMO])) break; if (sp > XB_SPIN_CAP) { atomicAdd(&bar[XB_TMO], 1u); break; } }
    }
    nloc = mine > 0u ? mine : 1u; nx = cnt > 0u ? cnt : 1u;
}
__device__ __forceinline__ void xcd_barrier(const XcdBarrier& b) {
    asm volatile("s_waitcnt vmcnt(0)" ::: "memory");
    __syncthreads();
    if (threadIdx.x == 0) {
        unsigned* bar = b.bar;
        __builtin_amdgcn_s_waitcnt(0);
        unsigned nloc = b.st[0], nx = b.st[1];
        if (nloc == 0u) { xcd_barrier_complete(bar, b.x, nloc, nx); b.st[0] = nloc; b.st[1] = nx; }
        const unsigned old = xb_add(&bar[XB_XSUB(b.x)], 1u);
        const unsigned gen = old / nloc;
        if (old + 1u == (gen + 1u) * nloc) {
            __builtin_amdgcn_fence(__ATOMIC_RELEASE, "agent");
            asm volatile("s_waitcnt vmcnt(0)" ::: "memory");
            const unsigned og = xb_add(&bar[XB_TOP], 1u);
            const unsigned tg = og / nx;
            if (og + 1u == (tg + 1u) * nx) xb_add(&bar[XB_TOPGEN], 1u);
            else XB_SPIN(xb_ld(&bar[XB_TOPGEN]) == tg, bar);
            __builtin_amdgcn_fence(__ATOMIC_ACQUIRE, "agent");
            xb_add(&bar[XB_XGEN(b.x)], 1u);
            asm volatile("s_waitcnt vmcnt(0)" ::: "memory");
        } else {
            XB_SPIN(xb_ld(&bar[XB_XGEN(b.x)]) == gen, bar);
            __builtin_amdgcn_fence(__ATOMIC_ACQUIRE, "agent");
            asm volatile("s_waitcnt vmcnt(0)" ::: "memory");
        }
    }
    __syncthreads();
}

__device__ const unsigned char kBucket[128] = {
    0, 1, 2, 3, 4, 5, 6, 7, 8, 9, 10, 11, 12, 13, 14, 15, 16, 16, 16, 17, 17, 18, 18, 18, 19, 19, 19, 20, 20, 20, 20, 21, 21, 21, 21, 22, 22, 22, 22, 22, 23, 23, 23, 23, 23, 23, 24, 24, 24, 24, 24, 24, 25, 25, 25, 25, 25, 25, 25, 26, 26, 26, 26, 26, 26, 26, 26, 27, 27, 27, 27, 27, 27, 27, 27, 27, 27, 28, 28, 28, 28, 28, 28, 28, 28, 28, 28, 29, 29, 29, 29, 29, 29, 29, 29, 29, 29, 29, 29, 30, 30, 30, 30, 30, 30, 30, 30, 30, 30, 30, 30, 30, 30, 31, 31, 31, 31, 31, 31, 31, 31, 31, 31, 31, 31, 31, 31, 31};

__device__ __forceinline__ void p0_transpose_item(const float* W, const float* gk, int K, int N, bf16* WT, LAS float* scr, int item, int lane, bool qscale = false) {
    const int nblk = N / 32, kb = item / nblk, nb = item % nblk, k0 = 64 * kb, n0 = 32 * nb;
    const float cs = (qscale && (n0 < 1024 || (n0 >= QS_OFF && n0 < KS_OFF))) ? 0.125f * 1.4426950408889634f : 1.0f;
#pragma unroll 8
    for (int i = 0; i < 32; ++i) { const int kk = 2 * i + (lane >> 5); float v = W[(size_t)(k0 + kk) * N + n0 + (lane & 31)]; if (gk) v *= gk[k0 + kk]; scr[kk * 33 + (lane & 31)] = v * cs; }
    LDS_WAIT(); asm volatile("" ::: "memory");
    const int c = lane & 7;
#pragma unroll
    for (int j = 0; j < 4; ++j) { const int n = (lane >> 3) + 8 * j; const LAS float* s = scr + (8 * c) * 33 + n;
        v4u o; o.x = pk2(s[0 * 33], s[1 * 33]); o.y = pk2(s[2 * 33], s[3 * 33]); o.z = pk2(s[4 * 33], s[5 * 33]); o.w = pk2(s[6 * 33], s[7 * 33]);
        *(GAS v4u*)(WT + (size_t)(n0 + n) * K + k0 + 8 * c) = o; }
    LDS_WAIT(); asm volatile("" ::: "memory");
}
__device__ __forceinline__ void row_cvt(const float* xrow, bf16* orow, float* rstd, int lane) {
    const f32x4* xr = (const f32x4*)xrow + lane;
    f32x4 v[8]; float s = 0.f;
#pragma unroll
    for (int j = 0; j < 8; ++j) { v[j] = xr[64 * j]; s += (v[j].x * v[j].x + v[j].y * v[j].y) + (v[j].z * v[j].z + v[j].w * v[j].w); }
    s = wave_sum(s);
    if (lane == 0) *rstd = 1.0f / sqrtf(s * (1.0f / DM) + EPS);
    unsigned long long* o8 = (unsigned long long*)orow + lane;
#pragma unroll
    for (int j = 0; j < 8; ++j) o8[64 * j] = (unsigned long long)pk2(v[j].x, v[j].y) | ((unsigned long long)pk2(v[j].z, v[j].w) << 32);
}

namespace att {
typedef short bf16x8 __attribute__((ext_vector_type(8)));
typedef short s16x4 __attribute__((ext_vector_type(4)));
typedef short v4i16_t __attribute__((ext_vector_type(4)));
typedef float f32x16 __attribute__((ext_vector_type(16)));
typedef unsigned u32x4 __attribute__((ext_vector_type(4)));
typedef float f32x2_t __attribute__((ext_vector_type(2))); typedef __bf16 bf16x2_t __attribute__((ext_vector_type(2)));
typedef LAS const char* lds_cptr;
constexpr float LOG2E = 1.4426950408889634f;
constexpr float QSCALE = 0.125f * LOG2E;
constexpr float SB_EXIT = 150.2f;
__device__ __forceinline__ int crow(int r, int hi) { return (r & 3) + 8 * (r >> 2) + 4 * hi; }
__device__ __forceinline__ unsigned cvtpk(float lo, float hi) { f32x2_t v = {lo, hi}; bf16x2_t b = __builtin_convertvector(v, bf16x2_t); return __builtin_bit_cast(unsigned, b); }
__device__ __forceinline__ s16x4 vtr(lds_cptr p) { return __builtin_bit_cast(s16x4, __builtin_amdgcn_ds_read_tr16_b64_v4i16((LAS v4i16_t*)p)); }
#define ATT_WAITV(n) asm volatile("s_waitcnt vmcnt(" #n ")" ::: "memory")
#define ATT_WAITL() asm volatile("s_waitcnt lgkmcnt(0)" ::: "memory")

__device__ __forceinline__ unsigned k_voff(int lane, int odd) { const int sw = (lane >> 4) + 4 * odd, c = (lane & 7) ^ sw; return (unsigned)((lane >> 3) * DIN * 2 + c * 16); }
__device__ __forceinline__ void dma_k(const bf16* src, LAS unsigned char* kreg, unsigned vk0, unsigned vk1) {
#pragma unroll
    for (int i = 0; i < 8; ++i) { const char* ub = (const char*)src + (size_t)i * (8 * DIN * 2);
        __builtin_amdgcn_global_load_lds((const unsigned*)(ub + ((i & 1) ? vk1 : vk0)), (LAS unsigned*)(kreg + i * 1024), 16, 0, 0); }
}
__device__ __forceinline__ unsigned v_voff(int lane) { return (unsigned)((lane >> 2) * DIN * 2 + (lane & 3) * 16); }
__device__ __forceinline__ void dma_v(const bf16* src, LAS unsigned char* vreg, unsigned vv) {
#pragma unroll
    for (int p = 0; p < 8; ++p) { const char* ub = (const char*)src + (size_t)(p & 3) * (16 * DIN * 2) + (p >> 2) * 64;
        __builtin_amdgcn_global_load_lds((const unsigned*)(ub + vv), (LAS unsigned*)(vreg + p * 1024), 16, 0, 0); }
}
__device__ __forceinline__ void load_kf(bf16x8 (&kf)[8], lds_cptr kreg, int r32, int hi) {
    const lds_cptr kp = kreg + r32 * 128; const int sw = (r32 >> 1) & 7;
#pragma unroll
    for (int d0 = 0; d0 < 4; ++d0) { const int off = ((2 * d0 + hi) ^ sw) * 16;
        kf[2 * d0] = *(const LAS bf16x8*)(kp + off); kf[2 * d0 + 1] = *(const LAS bf16x8*)(kp + 4096 + off); }
}
__device__ __forceinline__ void qkt(f32x16& p0, f32x16& p1, const bf16x8 (&kf)[8], const bf16x8 (&qr)[4]) {
    const f32x16 z = {};
    p0 = __builtin_amdgcn_mfma_f32_32x32x16_bf16(kf[0], qr[0], z, 0, 0, 0); p1 = __builtin_amdgcn_mfma_f32_32x32x16_bf16(kf[1], qr[0], z, 0, 0, 0);
#pragma unroll
    for (int d0 = 1; d0 < 4; ++d0) { p0 = __builtin_amdgcn_mfma_f32_32x32x16_bf16(kf[2 * d0], qr[d0], p0, 0, 0, 0); p1 = __builtin_amdgcn_mfma_f32_32x32x16_bf16(kf[2 * d0 + 1], qr[d0], p1, 0, 0, 0); }
}
__device__ __forceinline__ void pv(f32x16 (&o)[2], lds_cptr vp0, const f32x16& p0, const f32x16& p1) {
    u32x4 pw[4];
#pragma unroll
    for (int j = 0; j < 4; ++j) { pw[0][j] = cvtpk(p0[2 * j], p0[2 * j + 1]); pw[1][j] = cvtpk(p0[8 + 2 * j], p0[9 + 2 * j]); pw[2][j] = cvtpk(p1[2 * j], p1[2 * j + 1]); pw[3][j] = cvtpk(p1[8 + 2 * j], p1[9 + 2 * j]); }
#pragma unroll
    for (int d0 = 0; d0 < 2; ++d0)
#pragma unroll
        for (int ks = 0; ks < 4; ++ks) { const s16x4 lo = vtr(vp0 + d0 * 4096 + ks * 1024), hi4 = vtr(vp0 + d0 * 4096 + ks * 1024 + 512);
            const bf16x8 vf = (bf16x8){lo[0], lo[1], lo[2], lo[3], hi4[0], hi4[1], hi4[2], hi4[3]};
            o[d0] = __builtin_amdgcn_mfma_f32_32x32x16_bf16(__builtin_bit_cast(bf16x8, pw[ks]), vf, o[d0], 0, 0, 0); }
}
__device__ __forceinline__ float swap_other(float v) { auto rr = __builtin_amdgcn_permlane32_swap(__float_as_uint(v), __float_as_uint(v), false, false); return (threadIdx.x & 32) ? __uint_as_float(rr[0]) : __uint_as_float(rr[1]); }

template <bool SCALE> __device__ __forceinline__ void store_o(const f32x16 (&o)[2], LAS unsigned char* kreg, LAS float* wsf, bf16* y, float* slots, int tok0, int col0, int slot, int lane) {
    const int r32 = lane & 31, hi = lane >> 5;
    LAS float* stg = (LAS float*)kreg;
#pragma unroll
    for (int r = 0; r < 16; ++r) { const int row = crow(r, hi); stg[row * 64 + r32] = o[0][r]; stg[row * 64 + 32 + r32] = o[1][r]; }
    ATT_WAITL();
#pragma unroll
    for (int i = 0; i < 4; ++i) { const int row = i * 8 + (lane >> 3), ch = lane & 7;
        const f32x4 a = *(const LAS f32x4*)(stg + row * 64 + ch * 8), b = *(const LAS f32x4*)(stg + row * 64 + ch * 8 + 4);
        const float s = SCALE ? wsf[32 + row] : 1.0f;
        const f32x4 a2 = a * s, b2 = b * s;
        float ss = ((a2[0] * a2[0] + a2[1] * a2[1]) + (a2[2] * a2[2] + a2[3] * a2[3])) + ((b2[0] * b2[0] + b2[1] * b2[1]) + (b2[2] * b2[2] + b2[3] * b2[3]));
        ss += __shfl_xor(ss, 1); ss += __shfl_xor(ss, 2); ss += __shfl_xor(ss, 4);
        v4u w; w.x = cvtpk(a2[0], a2[1]); w.y = cvtpk(a2[2], a2[3]); w.z = cvtpk(b2[0], b2[1]); w.w = cvtpk(b2[2], b2[3]);
        *(GAS v4u*)(y + (size_t)(tok0 + row) * DM + col0 + ch * 8) = w;
        if (ch == 0) *(GAS float*)(slots + (size_t)(tok0 + row) * 32 + slot) = ss; }
    ATT_WAITL();
}

__device__ __forceinline__ void swa_item(const bf16* proj, LAS unsigned char* kreg, LAS unsigned char* vreg, LAS float* wsf, const LAS float* tab, float sink2, bf16* y, float* slots, int h, int q0, int lane) {
    const int r32 = lane & 31, hi = lane >> 5, kvh = h >> 3;
    const bf16* Kb = proj + KA_OFF + kvh * HD; const bf16* Vb = proj + VA_OFF + kvh * HD;
    const int kt_hi = q0 >> 6; int kt = kt_hi - 2 < 0 ? 0 : kt_hi - 2;
    const unsigned vk0 = k_voff(lane, 0), vk1 = k_voff(lane, 1), vv = v_voff(lane);
    dma_k(Kb + (size_t)kt * 64 * DIN, kreg, vk0, vk1); dma_v(Vb + (size_t)kt * 64 * DIN, vreg, vv);
    bf16x8 qr[4];
#pragma unroll
    for (int d0 = 0; d0 < 4; ++d0) qr[d0] = *(const GAS bf16x8*)(proj + (size_t)(q0 + r32) * DIN + QA_OFF + h * HD + d0 * 16 + hi * 8);
    const lds_cptr vp0 = (lds_cptr)vreg + ((lane >> 4) & 1) * 32 + (lane & 3) * 8 + (4 * hi + ((lane & 15) >> 2)) * 64;
    f32x16 o[2]; o[0] = f32x16{}; o[1] = f32x16{};
    float m = sink2, l = hi ? 0.f : 1.0f;
    const LAS float* tb = tab + h * 256;
    for (;; ++kt) {
        const bool more = kt < kt_hi;
        ATT_WAITV(8);
        bf16x8 kf[8]; load_kf(kf, (lds_cptr)kreg, r32, hi); ATT_WAITL();
        if (more) dma_k(Kb + (size_t)(kt + 1) * 64 * DIN, kreg, vk0, vk1);
        f32x16 p0, p1; qkt(p0, p1, kf, qr);
        const LAS float* t0 = tb + (191 - (q0 + r32 - 64 * kt - 4 * hi));
#pragma unroll
        for (int r = 0; r < 16; ++r) { const int cr = (r & 3) + 8 * (r >> 2); p0[r] += t0[cr]; p1[r] += t0[32 + cr]; }
        float rm = fmaxf(p0[0], p1[0]);
#pragma unroll
        for (int r = 1; r < 16; ++r) rm = fmaxf(rm, fmaxf(p0[r], p1[r]));
        rm = fmaxf(rm, swap_other(rm));
        const float mn = fmaxf(m, rm), f = __builtin_amdgcn_exp2f(m - mn); m = mn;
        float ps = 0.f;
#pragma unroll
        for (int r = 0; r < 16; ++r) { p0[r] = __builtin_amdgcn_exp2f(p0[r] - mn); p1[r] = __builtin_amdgcn_exp2f(p1[r] - mn); ps += p0[r] + p1[r]; }
        l = l * f + ps;
        if (__any(f != 1.0f)) {
            if (hi == 0) wsf[r32] = f;
            ATT_WAITL();
#pragma unroll
            for (int r = 0; r < 16; ++r) { const float fr_ = wsf[crow(r, hi)]; o[0][r] *= fr_; o[1][r] *= fr_; }
            ATT_WAITL();
        }
        if (more) ATT_WAITV(8); else ATT_WAITV(0);
        pv(o, vp0, p0, p1); ATT_WAITL();
        if (!more) break;
        dma_v(Vb + (size_t)(kt + 1) * 64 * DIN, vreg, vv);
    }
    l += swap_other(l);
    if (hi == 0) wsf[32 + r32] = 1.0f / l;
    ATT_WAITL();
    store_o<true>(o, kreg, wsf, y, slots, q0, h * HD, h, lane);
}

__device__ __forceinline__ void sb_item(const bf16* proj, LAS unsigned char* kreg, LAS unsigned char* vreg, bf16* y, float* slots, int h, int q0, int lane) {
    const int r32 = lane & 31, hi = lane >> 5;
    const bf16* Kb = proj + KS_OFF + h * HD; const bf16* Vb = proj + VS_OFF + h * HD;
    int kt = q0 >> 6;
    const unsigned vk0 = k_voff(lane, 0), vk1 = k_voff(lane, 1), vv = v_voff(lane);
    dma_k(Kb + (size_t)kt * 64 * DIN, kreg, vk0, vk1); dma_v(Vb + (size_t)kt * 64 * DIN, vreg, vv);
    bf16x8 qr[4];
#pragma unroll
    for (int d0 = 0; d0 < 4; ++d0) qr[d0] = *(const GAS bf16x8*)(proj + (size_t)(q0 + r32) * DIN + QS_OFF + h * HD + d0 * 16 + hi * 8);
    const lds_cptr vp0 = (lds_cptr)vreg + ((lane >> 4) & 1) * 32 + (lane & 3) * 8 + (4 * hi + ((lane & 15) >> 2)) * 64;
    f32x16 o[2]; o[0] = f32x16{}; o[1] = f32x16{};
    float R = 0.f;
    bool diag = true;
    for (;; --kt) {
        const bool more = kt > 0;
        ATT_WAITV(8);
        bf16x8 kf[8]; load_kf(kf, (lds_cptr)kreg, r32, hi); ATT_WAITL();
        if (more) dma_k(Kb + (size_t)(kt - 1) * 64 * DIN, kreg, vk0, vk1);
        f32x16 p0, p1; qkt(p0, p1, kf, qr);
        const int qrel = diag ? (q0 + r32 - 64 * kt - 4 * hi) : 1000;
        f32x16 e0, e1; float T[2][4];
#pragma unroll
        for (int r = 0; r < 16; ++r) { const int cr = (r & 3) + 8 * (r >> 2);
            float s0 = fmaxf(p0[r], 0.f) + __builtin_amdgcn_logf(1.0f + __builtin_amdgcn_exp2f(-fabsf(p0[r])));
            float s1 = fmaxf(p1[r], 0.f) + __builtin_amdgcn_logf(1.0f + __builtin_amdgcn_exp2f(-fabsf(p1[r])));
            e0[r] = (cr < qrel) ? s0 : 0.f; e1[r] = (cr + 32 < qrel) ? s1 : 0.f; }
#pragma unroll
        for (int w = 0; w < 4; ++w) { e0[4 * w + 2] += e0[4 * w + 3]; e0[4 * w + 1] += e0[4 * w + 2]; e0[4 * w] += e0[4 * w + 1]; T[0][w] = e0[4 * w];
                                      e1[4 * w + 2] += e1[4 * w + 3]; e1[4 * w + 1] += e1[4 * w + 2]; e1[4 * w] += e1[4 * w + 1]; T[1][w] = e1[4 * w]; }
        float run = R, base[2][4];
#pragma unroll
        for (int u = 1; u >= 0; --u)
#pragma unroll
            for (int w = 3; w >= 0; --w) { const float tp = swap_other(T[u][w]); const float rp = run + tp; base[u][w] = hi ? run : rp; run = rp + T[u][w]; }
#pragma unroll
        for (int r = 0; r < 16; ++r) { const int cr = (r & 3) + 8 * (r >> 2);
            const float a0 = __builtin_amdgcn_exp2f((p0[r] - base[0][r >> 2]) - e0[r]), a1 = __builtin_amdgcn_exp2f((p1[r] - base[1][r >> 2]) - e1[r]);
            p0[r] = (cr < qrel) ? a0 : 0.f; p1[r] = (cr + 32 < qrel) ? a1 : 0.f; }
        R = run;
        if (more) ATT_WAITV(8); else ATT_WAITV(0);
        pv(o, vp0, p0, p1); ATT_WAITL();
        if (!more || __all(R >= SB_EXIT)) break;
        dma_v(Vb + (size_t)(kt - 1) * 64 * DIN, vreg, vv);
        diag = false;
    }
    ATT_WAITV(0);
    store_o<false>(o, kreg, nullptr, y, slots, q0, 1024 + h * HD, 16 + h, lane);
}
#undef ATT_WAITV
#undef ATT_WAITL
}

struct Args { const float* in[14]; float* out; unsigned char* ws; };
__global__ void __launch_bounds__(NWAVES * 64, 2) mk_fwd(Args args) {
    extern __shared__ __attribute__((aligned(16))) unsigned char lds_raw[];
    LAS unsigned char* lds = (LAS unsigned char*)lds_raw;
    volatile LAS unsigned* MISC = (volatile LAS unsigned*)(lds + MISC_OFF);
    const int tid = threadIdx.x;
    const int G = gridDim.x; const int bx = blockIdx.x; const int vcu = (G % 8 == 0) ? (bx % 8) * (G / 8) + bx / 8 : bx;
    unsigned char* ws = args.ws;
    unsigned* ctl = (unsigned*)(ws + WS_CTL);
    const float* x = args.in[0]; const float* w_in = args.in[1]; const float* g_attn = args.in[2]; const float* rel_bias = args.in[3];
    const float* sinks = args.in[4]; const float* g_swa = args.in[5]; const float* g_sb = args.in[6]; const float* w_out = args.in[7];
    const float* g_mlp = args.in[8]; const float* w_up = args.in[9]; const float* w_conv = args.in[10]; const float* b_conv = args.in[11];
    const float* w_down = args.in[12]; const float* g_final = args.in[13];
    float* out = args.out;
    float* rstd1 = (float*)(ws + WS_RSTD1); float* ss2 = (float*)(ws + WS_SS2); float* ss3 = (float*)(ws + WS_SS3);
    bf16* WinT = (bf16*)(ws + WS_WIN); bf16* WoutT = (bf16*)(ws + WS_WOUT); bf16* WupT = (bf16*)(ws + WS_WUP); bf16* WdownT = (bf16*)(ws + WS_WDOWN);
    bf16* xb = (bf16*)(ws + WS_XB); bf16* proj = (bf16*)(ws + WS_PROJ); bf16* mix = (bf16*)(ws + WS_MIX);
    float* ssY = (float*)(ws + WS_SSY);
    bf16* gate = (bf16*)(ws + WS_GATE); bf16* val = (bf16*)(ws + WS_VAL);

    for (int u = tid; u < (LDS_BYTES - LDSCTL_OFF) / 4; u += NWAVES * 64) ((LAS unsigned*)(lds + LDSCTL_OFF))[u] = 0u;
    __syncthreads();
    XcdBarrier bar = xcd_barrier_post(ctl + CW_BAR, MISC + 8);
    const int NGW = G * NWAVES, NGT = G * NWAVES * 64;
#define PHASE_IDS() int tidp = threadIdx.x; asm volatile("" : "+v"(tidp)); const int lane = tidp & 63, wave = __builtin_amdgcn_readfirstlane(tidp >> 6); const int gw = vcu * NWAVES + wave, gt = vcu * (NWAVES * 64) + tidp; (void)lane; (void)gw; (void)gt

    {
        PHASE_IDS();
        LAS float* scr = (LAS float*)(lds + wave * 16384);
        constexpr int I_IN = (DM / 64) * (DIN / 32), I_OUT = (DM / 64) * (DM / 32), I_UP = (DM / 64) * (2 * DFF / 32), I_DOWN = (DFF / 64) * (DM / 32);
        constexpr int NITEMS = I_IN + I_OUT + I_UP + I_DOWN;
        for (int it = gw; it < NITEMS; it += NGW) {
            int r = it;
            if (r < I_IN) { p0_transpose_item(w_in, g_attn, DM, DIN, WinT, scr, r, lane, true); continue; } r -= I_IN;
            if (r < I_OUT) { p0_transpose_item(w_out, nullptr, DM, DM, WoutT, scr, r, lane); continue; } r -= I_OUT;
            if (r < I_UP) { p0_transpose_item(w_up, g_mlp, DM, 2 * DFF, WupT, scr, r, lane); continue; } r -= I_UP;
            p0_transpose_item(w_down, nullptr, DFF, DM, WdownT, scr, r, lane);
        }
        for (int m = gw; m < M; m += NGW) row_cvt(x + (size_t)m * DM, xb + (size_t)m * DM, rstd1 + m, lane);
    }
    xcd_barrier(bar);

    {
        pg8::Gemm g{xb, WinT, M, DIN, DM}; pg8::StaticOrder S; S.init(M, DIN, G, bx);
        pg8::EpiRowScaleBf16 E{proj, proj, DIN, 1 << 30, rstd1, nullptr};
        pg8::gemm_phase<pg8::EpiRowScaleBf16, pg8::StaticOrder, true, true>(lds, g, S, E);
    }
    xcd_barrier(bar);

    {
        PHASE_IDS();
        LAS float* tab = (LAS float*)(lds + ATT_TAB_OFF);
        for (int i = tidp; i < 16 * 256; i += NWAVES * 64) { const int h = i >> 8, dist = 191 - (i & 255);
            tab[i] = (dist >= 0 && dist < 128) ? rel_bias[kBucket[dist] * 16 + h] * att::LOG2E : -1e30f; }
        __syncthreads();
        LAS unsigned char* kreg = lds + wave * 16384; LAS unsigned char* vreg = kreg + 8192; LAS float* wsf = (LAS float*)(lds + ATT_WSF_OFF) + wave * 64;
        for (int tb = vcu; tb < M / 64; tb += G) {
            const int q0 = 64 * tb + 32 * (wave & 1);
            for (int hh = 0; hh < 4; ++hh) { const int h = 4 * (wave >> 1) + hh; att::swa_item(proj, kreg, vreg, wsf, tab, sinks[h] * att::LOG2E, mix, ssY, h, q0, lane); }
            for (int hh = 0; hh < 4; ++hh) { const int h = 4 * (wave >> 1) + hh; att::sb_item(proj, kreg, vreg, mix, ssY, h, q0, lane); }
        }
    }
    xcd_barrier(bar);

    { PHASE_IDS();
    for (int m = gw; m < M; m += NGW) {
        float s = (lane < 32) ? ssY[(size_t)m * 32 + lane] : 0.f;
        s += __shfl_xor(s, 1); s += __shfl_xor(s, 2); s += __shfl_xor(s, 4); s += __shfl_xor(s, 8);
        const float rA = 1.0f / sqrtf(__shfl(s, 0) * (1.0f / 1024) + EPS), rB = 1.0f / sqrtf(__shfl(s, 16) * (1.0f / 1024) + EPS);
        v4u* yr = (v4u*)(mix + (size_t)m * DM) + lane;
#pragma unroll
        for (int j = 0; j < 4; ++j) { const v4u v = yr[64 * j]; const int c = (lane + 64 * j) * 8; const float r = j < 2 ? rA : rB; const float* gp = (j < 2 ? g_swa + c : g_sb + (c - 1024));
            const f32x4 g0 = *(const f32x4*)gp, g1 = *(const f32x4*)(gp + 4);
            v4u o; o.x = pk2(bf2f(v.x & 0xffffu) * r * g0[0], bf2f(v.x >> 16) * r * g0[1]); o.y = pk2(bf2f(v.y & 0xffffu) * r * g0[2], bf2f(v.y >> 16) * r * g0[3]);
            o.z = pk2(bf2f(v.z & 0xffffu) * r * g1[0], bf2f(v.z >> 16) * r * g1[1]); o.w = pk2(bf2f(v.w & 0xffffu) * r * g1[2], bf2f(v.w >> 16) * r * g1[3]);
            yr[64 * j] = o; }
    } }
    xcd_barrier(bar);

    {
        pg8::Gemm g{mix, WoutT, M, DM, DM}; pg8::StaticOrder S; S.init(M, DM, G, bx);
        pg8::EpiResidual E{x, out, xb, DM, ss2};
        pg8::gemm_phase<pg8::EpiResidual, pg8::StaticOrder, true, true>(lds, g, S, E);
    }
    xcd_barrier(bar);

    {
        pg8::Gemm g{xb, WupT, M, 2 * DFF, DM}; pg8::StaticOrder S; S.init(M, 2 * DFF, G, bx);
        pg8::EpiRowScaleBf16 E{gate, val, DFF, DFF / 256, nullptr, ss2};
        pg8::gemm_phase<pg8::EpiRowScaleBf16, pg8::StaticOrder, true, true>(lds, g, S, E);
    }
    xcd_barrier(bar);

    { PHASE_IDS();
    for (size_t i = gt; i < (size_t)M * (DFF / 8); i += NGT) {
        const int t = (int)(i / (DFF / 8)), c = (int)(i % (DFF / 8)) * 8; const size_t idx = (size_t)t * DFF + c;
        const v4u g2 = *(const v4u*)(gate + idx), vv = *(const v4u*)(val + idx);
        v4u g1 = (v4u){0u, 0u, 0u, 0u}, g0 = (v4u){0u, 0u, 0u, 0u};
        if (t >= 1) g1 = *(const v4u*)(gate + idx - DFF);
        if (t >= 2) g0 = *(const v4u*)(gate + idx - 2 * DFF);
        float r[8];
#pragma unroll
        for (int e = 0; e < 8; ++e) {
            const unsigned w2 = g2[e >> 1], w1 = g1[e >> 1], w0 = g0[e >> 1], wv = vv[e >> 1];
            const float a2 = (e & 1) ? bf2f(w2 >> 16) : bf2f(w2 & 0xffffu), a1 = (e & 1) ? bf2f(w1 >> 16) : bf2f(w1 & 0xffffu), a0 = (e & 1) ? bf2f(w0 >> 16) : bf2f(w0 & 0xffffu);
            const float v = (e & 1) ? bf2f(wv >> 16) : bf2f(wv & 0xffffu);
            const float gc = b_conv[c + e] + a0 * w_conv[c + e] + a1 * w_conv[DFF + c + e] + a2 * w_conv[2 * DFF + c + e];
            r[e] = gc / (1.0f + expf(-gc)) * v;
        }
        v4u o; o.x = pk2(r[0], r[1]); o.y = pk2(r[2], r[3]); o.z = pk2(r[4], r[5]); o.w = pk2(r[6], r[7]);
        *(v4u*)(val + idx) = o;
    } }
    xcd_barrier(bar);

    {
        pg8::Gemm g{val, WdownT, M, DM, DFF}; pg8::StaticOrder S; S.init(M, DM, G, bx);
        pg8::EpiResidual E{out, out, nullptr, DM, ss3};
        pg8::gemm_phase<pg8::EpiResidual, pg8::StaticOrder, true, true>(lds, g, S, E);
    }
    xcd_barrier(bar);

    {
        PHASE_IDS();
        const unsigned tmo = xb_ld(ctl + CW_BAR + XB_TMO);
        for (int m = gw; m < M; m += NGW) {
            float s = (lane < 32) ? ss3[(size_t)m * 32 + lane] : 0.f; s = wave_sum(s);
            float r = 1.0f / sqrtf(s * (1.0f / DM) + EPS);
            if (tmo) r = __builtin_nanf("");
            f32x4* xr = (f32x4*)(out + (size_t)m * DM) + lane; const f32x4* gr = (const f32x4*)g_final + lane;
#pragma unroll
            for (int j = 0; j < 8; ++j) { const f32x4 v = xr[64 * j]; xr[64 * j] = v * r * gr[64 * j]; }
        }
    }
}

extern "C" void kernel_launch(void* const* d_in, const int* in_sizes, int n_in, void* d_out, int out_size, void* d_ws, size_t ws_size, hipStream_t stream) {
    static int grid = 0;
    if (grid == 0) {
        if (n_in != 14 || out_size != M * DM || ws_size < WS_END) { fprintf(stderr, "kernel_launch: unexpected shapes (n_in %d out %d ws %zu)\n", n_in, out_size, ws_size); grid = -1; return; }
        int dev = 0, cus = 0, per_cu = 0;
        if (hipGetDevice(&dev) != hipSuccess || hipDeviceGetAttribute(&cus, hipDeviceAttributeMultiprocessorCount, dev) != hipSuccess) { grid = -1; return; }
        if (hipFuncSetAttribute((const void*)mk_fwd, hipFuncAttributeMaxDynamicSharedMemorySize, LDS_BYTES) != hipSuccess) { fprintf(stderr, "kernel_launch: hipFuncSetAttribute failed\n"); grid = -1; return; }
        if (hipOccupancyMaxActiveBlocksPerMultiprocessor(&per_cu, (const void*)mk_fwd, NWAVES * 64, LDS_BYTES) != hipSuccess || per_cu < 1) { fprintf(stderr, "kernel_launch: occupancy query reports %d\n", per_cu); }
        (void)hipGetLastError();
        grid = cus;
    }
    if (grid < 0) return;
    if (hipMemsetAsync((char*)d_ws + WS_CTL, 0, CTL_ZERO_BYTES, stream) != hipSuccess) return;
    Args a{};
    for (int i = 0; i < 14; ++i) a.in[i] = (const float*)d_in[i];
    a.out = (float*)d_out; a.ws = (unsigned char*)d_ws;
    hipLaunchKernelGGL(mk_fwd, dim3(grid), dim3(NWAVES * 64), LDS_BYTES, stream, a);
}
```

```cpp
#include <hip/hip_runtime.h>
#include <cstdint>
#include <cstdio>

namespace pg8 {
#define PG8_LAS __attribute__((address_space(3)))
#define PG8_GAS __attribute__((address_space(1)))
typedef unsigned short bf16_t;
typedef short bf16x8 __attribute__((ext_vector_type(8)));
typedef float f32x4 __attribute__((ext_vector_type(4)));
typedef unsigned u32x4 __attribute__((ext_vector_type(4)));
typedef unsigned u32x2 __attribute__((ext_vector_type(2)));
constexpr int BM = 256, BK = 64, HALF = 128, HTB = HALF * BK * 2  , STAGE_BYTES = 8 * HTB, NXCD = 8, WGM = 8;

__host__ __device__ __forceinline__ int lds_byte(int r, int c) { const int st = (r >> 4) * 2 + (c >> 5), rr = r & 15, cc = c & 31, ob = rr * 64 + cc * 2; return st * 1024 + (ob ^ (((ob >> 9) & 1) << 5)); }
__host__ __device__ __forceinline__ void stage_rc(int b, int& R, int& C) { const int st = b / 1024, sb = b % 1024, swz = sb ^ (((sb >> 9) & 1) << 5); R = (st >> 1) * 16 + swz / 64; C = (st & 1) * 32 + (swz % 64) / 2; }
__host__ __device__ __forceinline__ int perm32(int rho) { const int n = rho >> 4, i = rho & 15; return 8 * (i >> 2) + 4 * n + (i & 3); }

struct Unit { int pm, pn; };
struct Gemm { const bf16_t* A; const bf16_t* Bt; int M, N, K; };

struct StaticOrder {
    int nM, nN, nwg, G, c;
    __host__ __device__ void init(int M, int N, int G_, int c_) { nM = M / BM; nN = N / BM; nwg = nM * nN; G = G_; c = c_; }
    __host__ __device__ bool next(int i, Unit& u) const {
        const long L = (long)i * G + c; if (L >= nwg) return false;
        int wgid = (int)L; { const int q = nwg / NXCD, r = nwg % NXCD, xcd = wgid % NXCD, off = wgid / NXCD; wgid = (xcd < r ? xcd * (q + 1) : r * (q + 1) + (xcd - r) * q) + off; }
        const int nig = WGM * nN, gid = wgid / nig, fm = gid * WGM, gsz = (nM - fm) < WGM ? (nM - fm) : WGM;
        u.pm = fm + ((wgid % nig) % gsz); u.pn = (wgid % nig) / gsz; return true;
    }
    __device__ __forceinline__ void a_ready(const Unit&) const {}
    __device__ __forceinline__ void done(const Unit&) const {}
};

__device__ __forceinline__ unsigned cvt_pk_bf16(float lo, float hi) { unsigned r; asm volatile("v_cvt_pk_bf16_f32 %0, %1, %2" : "=v"(r) : "v"(lo), "v"(hi)); return r; }

struct EpiRowScaleBf16 {
    static constexpr bool PERM = true, AFTER_DRAIN = false;
    bf16_t* O; bf16_t* O2; int ldc; int split_pn; const float* rs; const float* slots;
    __device__ __forceinline__ void operator()(const f32x4 (&acc)[2][2][4][2], const Unit& u, int wr, int wc, int fr, int fq) const {
        const int row0 = u.pm * BM + wr * 64 + fr; int pn = u.pn; bf16_t* base = O;
        if (pn >= split_pn) { pn -= split_pn; base = O2; }
        const int col0 = pn * BM + wc * 32 + 8 * fq;
        float sc[2][4];
#pragma unroll
        for (int ai = 0; ai < 2; ++ai)
#pragma unroll
            for (int m = 0; m < 4; ++m) {
                const int r = row0 + ai * HALF + m * 16;
                if (rs) sc[ai][m] = *(const PG8_GAS float*)(rs + r);
                else { const PG8_GAS f32x4* sp = (const PG8_GAS f32x4*)(slots + (size_t)r * 32 + fq * 8); const f32x4 a = sp[0], b = sp[1];
                    float s = ((a[0] + a[1]) + (a[2] + a[3])) + ((b[0] + b[1]) + (b[2] + b[3])); s += __shfl_xor(s, 16); s += __shfl_xor(s, 32);
                    sc[ai][m] = 1.0f / sqrtf(s * (1.0f / 2048.0f) + 1e-6f); }
            }
#pragma unroll
        for (int ai = 0; ai < 2; ++ai)
#pragma unroll
            for (int m = 0; m < 4; ++m) { bf16_t* rowp = base + (size_t)(row0 + ai * HALF + m * 16) * ldc + col0; const float s = sc[ai][m];
#pragma unroll
                for (int bj = 0; bj < 2; ++bj) { const f32x4 v0 = acc[ai][bj][m][0] * s, v1 = acc[ai][bj][m][1] * s;
                    u32x4 w; w.x = cvt_pk_bf16(v0[0], v0[1]); w.y = cvt_pk_bf16(v0[2], v0[3]); w.z = cvt_pk_bf16(v1[0], v1[1]); w.w = cvt_pk_bf16(v1[2], v1[3]);
                    *(u32x4*)(rowp + bj * HALF) = w; } }
    }
};
struct EpiResidual {
    static constexpr bool PERM = false, AFTER_DRAIN = false;
    const float* base; float* out; bf16_t* ob; int ldc; float* slots;
    __device__ __forceinline__ void operator()(const f32x4 (&acc)[2][2][4][2], const Unit& u, int wr, int wc, int fr, int fq) const {
        const int row0 = u.pm * BM + wr * 64 + fr, col0 = u.pn * BM + wc * 32 + 4 * fq;
#pragma unroll
        for (int ai = 0; ai < 2; ++ai)
#pragma unroll
            for (int m = 0; m < 4; ++m) { const int r = row0 + ai * HALF + m * 16; const size_t off = (size_t)r * ldc + col0; float ss = 0.f;
#pragma unroll
                for (int bj = 0; bj < 2; ++bj)
#pragma unroll
                    for (int n = 0; n < 2; ++n) { const f32x4 v = *(const f32x4*)(base + off + bj * HALF + n * 16) + acc[ai][bj][m][n];
                        *(f32x4*)(out + off + bj * HALF + n * 16) = v; ss += (v[0] * v[0] + v[1] * v[1]) + (v[2] * v[2] + v[3] * v[3]);
                        if (ob) { u32x2 w; w.x = cvt_pk_bf16(v[0], v[1]); w.y = cvt_pk_bf16(v[2], v[3]); *(u32x2*)(ob + off + bj * HALF + n * 16) = w; } }
                ss += __shfl_xor(ss, 16); ss += __shfl_xor(ss, 32);
                if (fq == 0) slots[(size_t)r * 32 + u.pn * 4 + wc] = ss; }
    }
};

__device__ __forceinline__ float dpp_ror1(float v) { return __builtin_bit_cast(float, __builtin_amdgcn_update_dpp(0, __builtin_bit_cast(int, v), 0x121, 0xf, 0xf, false)); }
__device__ __forceinline__ float dpp_ror2(float v) { return __builtin_bit_cast(float, __builtin_amdgcn_update_dpp(0, __builtin_bit_cast(int, v), 0x122, 0xf, 0xf, false)); }
__device__ __forceinline__ float silu_mul(float gc, float v) { return gc * v * __builtin_amdgcn_rcpf(1.0f + __builtin_amdgcn_exp2f(gc * -1.4426950408889634f)); }
struct EpiConvGlu {
    static constexpr bool PERM = true, AFTER_DRAIN = false;
    bf16_t* act; int ldc; const float* slots; const float* wconv; const float* bconv; float* GF; float* VF; float* GL;
    __device__ __forceinline__ void operator()(const f32x4 (&acc)[2][2][4][2], const Unit& u, int wr, int wc, int fr, int fq) const {
        const int row0 = u.pm * BM + wr * 64 + fr, col0 = u.pn * HALF + wc * 32 + 8 * fq;
        f32x4 w0[2], w1[2], w2[2], bb[2];
#pragma unroll
        for (int n = 0; n < 2; ++n) { w0[n] = *(const PG8_GAS f32x4*)(wconv + col0 + 4 * n); w1[n] = *(const PG8_GAS f32x4*)(wconv + ldc + col0 + 4 * n); w2[n] = *(const PG8_GAS f32x4*)(wconv + 2 * ldc + col0 + 4 * n); bb[n] = *(const PG8_GAS f32x4*)(bconv + col0 + 4 * n); }
        const bool f0 = fr == 0, f01 = fr < 2;
#pragma unroll
        for (int ai = 0; ai < 2; ++ai) {
            f32x4 g[4][2], v[4][2];
#pragma unroll
            for (int m = 0; m < 4; ++m) { const int r = row0 + ai * HALF + m * 16;
                const PG8_GAS f32x4* sp = (const PG8_GAS f32x4*)(slots + (size_t)r * 32 + fq * 8); const f32x4 a = sp[0], b = sp[1];
                float s = ((a[0] + a[1]) + (a[2] + a[3])) + ((b[0] + b[1]) + (b[2] + b[3])); s += __shfl_xor(s, 16); s += __shfl_xor(s, 32);
                const float sc = 1.0f / sqrtf(s * (1.0f / 2048.0f) + 1e-6f);
#pragma unroll
                for (int n = 0; n < 2; ++n) { g[m][n] = acc[ai][0][m][n] * sc; v[m][n] = acc[ai][1][m][n] * sc; } }
            const int G = (u.pm * BM + ai * HALF + wr * 64) >> 6;
            if (f01) { float* gp = GF + ((size_t)G * 2 + fr) * ldc + col0; float* vp = VF + ((size_t)G * 2 + fr) * ldc + col0;
                *(PG8_GAS f32x4*)gp = g[0][0]; *(PG8_GAS f32x4*)(gp + 4) = g[0][1]; *(PG8_GAS f32x4*)vp = v[0][0]; *(PG8_GAS f32x4*)(vp + 4) = v[0][1]; }
            if (fr >= 14) { float* gp = GL + ((size_t)G * 2 + (fr - 14)) * ldc + col0; *(PG8_GAS f32x4*)gp = g[3][0]; *(PG8_GAS f32x4*)(gp + 4) = g[3][1]; }
            unsigned wpk[4][4];
#pragma unroll
            for (int n = 0; n < 2; ++n)
#pragma unroll
                for (int jp = 0; jp < 2; ++jp) { float o[4][2];
#pragma unroll
                    for (int jj = 0; jj < 2; ++jj) { const int j = 2 * jp + jj; float T[4], U[4];
#pragma unroll
                        for (int m = 0; m < 4; ++m) { T[m] = dpp_ror1(g[m][n][j]); U[m] = dpp_ror2(g[m][n][j]); }
#pragma unroll
                        for (int m = 0; m < 4; ++m) { const float g1 = (m > 0 && f0) ? T[m > 0 ? m - 1 : 0] : T[m], g2 = (m > 0 && f01) ? U[m > 0 ? m - 1 : 0] : U[m];
                            const float gc = bb[n][j] + w0[n][j] * g2 + w1[n][j] * g1 + w2[n][j] * g[m][n][j];
                            o[m][jj] = silu_mul(gc, v[m][n][j]); } }
#pragma unroll
                    for (int m = 0; m < 4; ++m) wpk[m][2 * n + jp] = cvt_pk_bf16(o[m][0], o[m][1]);
                    asm volatile("" ::: "memory"); }
#pragma unroll
            for (int m = 0; m < 4; ++m) { u32x4 w; w.x = wpk[m][0]; w.y = wpk[m][1]; w.z = wpk[m][2]; w.w = wpk[m][3];
                if (m > 0 || !f01) *(u32x4*)(act + (size_t)(row0 + ai * HALF + m * 16) * ldc + col0) = w; }
        }
    }
};

template <class Epi, class Sched, bool ALIGN_EPI = false, bool SP2 = false>
__device__ __forceinline__ void gemm_phase(PG8_LAS unsigned char* lds, const Gemm g, const Sched& S, const Epi& E) {
    int tid = threadIdx.x; asm volatile("" : "+v"(tid));
    const int wid = __builtin_amdgcn_readfirstlane(tid >> 6), lane = tid & 63, wr = wid >> 2, wc = wid & 3, fr = lane & 15, fq = lane >> 4;
    const int K = g.K, nt = K / BK;
    unsigned voffA[2], voffB[2];
#pragma unroll
    for (int i = 0; i < 2; ++i) { int R, C; stage_rc(tid * 16 + i * 8192, R, C); const int Rb = Epi::PERM ? ((R & ~31) + perm32(R & 31)) : R;
        voffA[i] = (unsigned)(R * K + C) * 2u; voffB[i] = (unsigned)(Rb * K + C) * 2u; }
    const size_t kstep = (size_t)(BK * 2);
    const size_t hstep = (size_t)HALF * K * 2;
    const size_t tstep = 2 * hstep;
    const unsigned ldsw = (unsigned)wid * 1024u;
    const int aoff = lds_byte(wr * 64 + fr, fq * 8), boff = lds_byte(wc * 32 + fr, fq * 8);
#define PG8_SA(b, h) (((b) * 2 + (h)) * HTB)
#define PG8_SB(b, h) ((4 + (b) * 2 + (h)) * HTB)
#define PG8_STAGE(bufoff, gbase, voff) do { _Pragma("unroll") for (int _i = 0; _i < 2; ++_i) \
        __builtin_amdgcn_global_load_lds((const unsigned*)((const char*)(gbase) + (voff)[_i]), (PG8_LAS unsigned*)(lds + (bufoff) + ldsw + _i * 8192), 16, 0, 0); } while (0)
#define PG8_LDA(dst, b, h) do { _Pragma("unroll") for (int m = 0; m < 4; ++m) _Pragma("unroll") for (int k = 0; k < 2; ++k) dst[m][k] = *(const PG8_LAS bf16x8*)(lds + PG8_SA(b, h) + aoff + m * 2048 + k * 1024); } while (0)
#define PG8_LDB(dst, b, h) do { _Pragma("unroll") for (int n = 0; n < 2; ++n) _Pragma("unroll") for (int k = 0; k < 2; ++k) dst[n][k] = *(const PG8_LAS bf16x8*)(lds + PG8_SB(b, h) + boff + n * 2048 + k * 1024); } while (0)
#define PG8_MMA(ai, bj, At, Bt) do { __builtin_amdgcn_s_setprio(1); _Pragma("unroll") for (int m = 0; m < 4; ++m) _Pragma("unroll") for (int n = 0; n < 2; ++n) _Pragma("unroll") for (int k = 0; k < 2; ++k) \
        acc[ai][bj][m][n] = __builtin_amdgcn_mfma_f32_16x16x32_bf16(Bt[n][k], At[m][k], acc[ai][bj][m][n], 0, 0, 0); __builtin_amdgcn_s_setprio(0); } while (0)
#define PG8_WAIT_V(n) asm volatile("s_waitcnt vmcnt(" #n ")" ::: "memory")
#define PG8_WAIT_L(n) asm volatile("s_waitcnt lgkmcnt(" #n ")" ::: "memory")
#define PG8_BAR __builtin_amdgcn_s_barrier()
#define PG8_SCHED __builtin_amdgcn_sched_barrier(0)
    Unit cur, nxt; int ui = 0;
    if (!S.next(0, cur)) return;
    f32x4 acc[2][2][4][2];
#pragma unroll
    for (int a = 0; a < 2; ++a)
#pragma unroll
        for (int b = 0; b < 2; ++b)
#pragma unroll
            for (int m = 0; m < 4; ++m)
#pragma unroll
                for (int n = 0; n < 2; ++n) acc[a][b][m][n] = (f32x4){0.f, 0.f, 0.f, 0.f};
    bf16x8 At[4][2], B0[2][2], B1[2][2];
    const char* cA = (const char*)g.A + (size_t)cur.pm * tstep; const char* cB = (const char*)g.Bt + (size_t)cur.pn * tstep;
    S.a_ready(cur);
    if constexpr (SP2) {
        PG8_STAGE(PG8_SB(0, 0), cB, voffB); PG8_STAGE(PG8_SB(0, 1), cB + hstep, voffB); PG8_STAGE(PG8_SA(0, 0), cA, voffA); PG8_STAGE(PG8_SA(0, 1), cA + hstep, voffA);
        if (wr == 1) PG8_BAR;
        PG8_WAIT_V(2); PG8_BAR;
        PG8_STAGE(PG8_SB(1, 0), cB + kstep, voffB); PG8_STAGE(PG8_SA(1, 0), cA + kstep, voffA); PG8_STAGE(PG8_SB(1, 1), cB + hstep + kstep, voffB);
        PG8_WAIT_V(6); PG8_BAR;
    } else {
        PG8_STAGE(PG8_SB(0, 0), cB, voffB); PG8_STAGE(PG8_SA(0, 0), cA, voffA); PG8_STAGE(PG8_SB(0, 1), cB + hstep, voffB); PG8_STAGE(PG8_SA(0, 1), cA + hstep, voffA);
        if (wr == 1) PG8_BAR;
        PG8_WAIT_V(4); PG8_BAR;
        PG8_STAGE(PG8_SB(1, 0), cB + kstep, voffB); PG8_STAGE(PG8_SA(1, 0), cA + kstep, voffA); PG8_STAGE(PG8_SB(1, 1), cB + hstep + kstep, voffB);
        PG8_WAIT_V(6); PG8_BAR;
    }
    for (;;) {
        const bool has_next = S.next(ui + 1, nxt);
        const char* nA = has_next ? (const char*)g.A + (size_t)nxt.pm * tstep : cA; const char* nB = has_next ? (const char*)g.Bt + (size_t)nxt.pn * tstep : cB;
        for (int t = 0; t < nt; t += 2) {
            const bool last = (t == nt - 2);
            const char* a1 = cA + (size_t)(t + 1) * kstep;
            const char* a2 = last ? nA : cA + (size_t)(t + 2) * kstep; const char* b2 = last ? nB : cB + (size_t)(t + 2) * kstep;
            const char* a3 = a2 + kstep; const char* b3 = b2 + kstep;
            if (last && has_next) S.a_ready(nxt);
            if constexpr (SP2) {
            PG8_LDB(B0, 0, 0); PG8_LDB(B1, 0, 1); PG8_SCHED; PG8_LDA(At, 0, 0); PG8_STAGE(PG8_SA(1, 1), a1 + hstep, voffA);
            PG8_WAIT_V(8); PG8_WAIT_L(0); PG8_BAR; PG8_MMA(0, 0, At, B0); PG8_MMA(0, 1, At, B1); PG8_BAR; PG8_SCHED;
            PG8_LDA(At, 0, 1); PG8_STAGE(PG8_SB(0, 0), b2, voffB); PG8_STAGE(PG8_SB(0, 1), b2 + hstep, voffB); PG8_STAGE(PG8_SA(0, 0), a2, voffA);
            PG8_WAIT_V(8); PG8_WAIT_L(0); PG8_BAR; PG8_MMA(1, 0, At, B0); PG8_MMA(1, 1, At, B1); PG8_BAR; PG8_SCHED;
            PG8_LDB(B0, 1, 0); PG8_LDB(B1, 1, 1); PG8_SCHED; PG8_LDA(At, 1, 0); PG8_STAGE(PG8_SA(0, 1), a2 + hstep, voffA);
            PG8_WAIT_V(8); PG8_WAIT_L(0); PG8_BAR; PG8_MMA(0, 0, At, B0); PG8_MMA(0, 1, At, B1); PG8_BAR; PG8_SCHED;
            PG8_LDA(At, 1, 1); PG8_STAGE(PG8_SB(1, 0), b3, voffB); PG8_STAGE(PG8_SB(1, 1), b3 + hstep, voffB); PG8_STAGE(PG8_SA(1, 0), a3, voffA);
            PG8_WAIT_V(8); PG8_WAIT_L(0); PG8_BAR; PG8_MMA(1, 0, At, B0); PG8_MMA(1, 1, At, B1); PG8_BAR; PG8_SCHED;
            } else {
            PG8_LDB(B0, 0, 0); PG8_SCHED; PG8_LDA(At, 0, 0); PG8_STAGE(PG8_SA(1, 1), a1 + hstep, voffA);
            PG8_WAIT_L(8); PG8_BAR; PG8_WAIT_L(0); PG8_MMA(0, 0, At, B0); PG8_BAR; PG8_SCHED;
            PG8_LDB(B1, 0, 1); PG8_STAGE(PG8_SB(0, 0), b2, voffB);
            PG8_BAR; PG8_WAIT_L(0); PG8_MMA(0, 1, At, B1); PG8_BAR;
            PG8_LDA(At, 0, 1); PG8_STAGE(PG8_SA(0, 0), a2, voffA);
            PG8_BAR; PG8_WAIT_L(0); PG8_MMA(1, 0, At, B0); PG8_BAR; PG8_SCHED;
            PG8_STAGE(PG8_SB(0, 1), b2 + hstep, voffB);
            PG8_WAIT_V(6); PG8_BAR; PG8_MMA(1, 1, At, B1); PG8_BAR;
            PG8_LDB(B0, 1, 0); PG8_SCHED; PG8_LDA(At, 1, 0); PG8_STAGE(PG8_SA(0, 1), a2 + hstep, voffA);
            PG8_WAIT_L(8); PG8_BAR; PG8_WAIT_L(0); PG8_MMA(0, 0, At, B0); PG8_BAR; PG8_SCHED;
            PG8_LDB(B1, 1, 1); PG8_STAGE(PG8_SB(1, 0), b3, voffB);
            PG8_BAR; PG8_WAIT_L(0); PG8_MMA(0, 1, At, B1); PG8_BAR;
            PG8_LDA(At, 1, 1); PG8_STAGE(PG8_SA(1, 0), a3, voffA);
            PG8_BAR; PG8_WAIT_L(0); PG8_MMA(1, 0, At, B0); PG8_BAR; PG8_SCHED;
            PG8_STAGE(PG8_SB(1, 1), b3 + hstep, voffB);
            PG8_WAIT_V(6); PG8_BAR; PG8_MMA(1, 1, At, B1); PG8_BAR;
            }
        }
        if constexpr (ALIGN_EPI) { if (wr == 0) PG8_BAR; }
        if constexpr (!Epi::AFTER_DRAIN) { E(acc, cur, wr, wc, fr, fq); S.done(cur); }
        if (!has_next) break;
#pragma unroll
        for (int a = 0; a < 2; ++a)
#pragma unroll
            for (int b = 0; b < 2; ++b)
#pragma unroll
                for (int m = 0; m < 4; ++m)
#pragma unroll
                    for (int n = 0; n < 2; ++n) acc[a][b][m][n] = (f32x4){0.f, 0.f, 0.f, 0.f};
        cur = nxt; cA = nA; cB = nB; ++ui;
        if constexpr (ALIGN_EPI) { if (wr == 1) PG8_BAR; }
    }
    PG8_WAIT_V(0);
    if constexpr (!ALIGN_EPI) { if (wr == 0) PG8_BAR; }
    PG8_BAR;
#undef PG8_SA
#undef PG8_SB
#undef PG8_STAGE
#undef PG8_LDA
#undef PG8_LDB
#undef PG8_MMA
#undef PG8_WAIT_V
#undef PG8_WAIT_L
#undef PG8_BAR
#undef PG8_SCHED
}
}

constexpr int NWAVES = 8;
constexpr int M = 16384, DM = 2048, DIN = 4352, DFF = 5632, HD = 64;
constexpr int QA_OFF = 0, KA_OFF = 1024, VA_OFF = 1152, QS_OFF = 1280, KS_OFF = 2304, VS_OFF = 3328;
constexpr float EPS = 1e-6f;

constexpr size_t MiB = 1u << 20;
constexpr size_t WS_CTL = 0, CTL_ZERO_BYTES = 64 * 1024;
constexpr size_t WS_RSTD1 = 1 * MiB;
constexpr size_t WS_SS2 = 2 * MiB, WS_SS3 = 4 * MiB, WS_SSY = 6 * MiB;
constexpr size_t WS_WUP = 8 * MiB;
constexpr size_t WS_WDOWN = 52 * MiB;
constexpr size_t WS_XB = 74 * MiB;
constexpr size_t WS_ACT = 138 * MiB;
constexpr size_t WS_GF = 364 * MiB, WS_VF = 376 * MiB, WS_GL = 388 * MiB;
constexpr size_t WS_WIN = 138 * MiB;
constexpr size_t WS_WOUT = 155 * MiB;
constexpr size_t WS_PROJ = 163 * MiB;
constexpr size_t WS_MIX = 299 * MiB;
constexpr size_t WS_END = 400 * MiB;
constexpr int CW_BAR = 4096;

constexpr int RING_BYTES = 131072, ATT_TAB_OFF = RING_BYTES  , ATT_WSF_OFF = ATT_TAB_OFF + 16384  , LDSCTL_OFF = ATT_WSF_OFF + 2048, MISC_OFF = LDSCTL_OFF + 320, LDS_BYTES = 155648;

#define GAS __attribute__((address_space(1)))
#define LAS __attribute__((address_space(3)))
typedef unsigned short bf16;
typedef unsigned v4u __attribute__((ext_vector_type(4)));
typedef float f32x4 __attribute__((ext_vector_type(4)));
#define LDS_WAIT() asm volatile("s_waitcnt lgkmcnt(0)" ::: "memory")
__device__ __forceinline__ unsigned f2bf(float f) { unsigned u = __builtin_bit_cast(unsigned, f); return (u + 0x7fffu + ((u >> 16) & 1u)) >> 16; }
__device__ __forceinline__ unsigned pk2(float lo, float hi) { return f2bf(lo) | (f2bf(hi) << 16); }
__device__ __forceinline__ float bf2f(unsigned h) { return __builtin_bit_cast(float, h << 16); }
__device__ __forceinline__ float wave_sum(float v) {
#pragma unroll
    for (int o = 1; o < 64; o <<= 1) v += __shfl_xor(v, o);
    return v;
}

#define XB_TMO      128
#define XB_XCNT(j)  (256  + 64 * (j))
#define XB_XSUB(j)  (1280 + 64 * (j))
#define XB_XGEN(j)  (2304 + 64 * (j))
#define XB_TOP      3328
#define XB_TOPGEN   3392
#define XCD_BAR_WORDS 3456
#define XB_SPIN_CAP (1u << 18)
__device__ __forceinline__ unsigned xb_ld(unsigned* p)              { return __hip_atomic_load(p, __ATOMIC_RELAXED, __HIP_MEMORY_SCOPE_AGENT); }
__device__ __forceinline__ unsigned xb_add(unsigned* p, unsigned v) { return __hip_atomic_fetch_add(p, v, __ATOMIC_RELAXED, __HIP_MEMORY_SCOPE_AGENT); }
__device__ __forceinline__ unsigned xb_xcc_id() { return (unsigned)__builtin_amdgcn_s_getreg((3 << 11) | 20) & 0xFu; }
#define XB_SPIN(cond, bar) do { unsigned _sp = 0; while (cond) { __builtin_amdgcn_s_sleep(1); \
    if ((++_sp & 255u) == 0u) { if (xb_ld(&(bar)[XB_TMO])) break; if (_sp > XB_SPIN_CAP) { atomicAdd(&(bar)[XB_TMO], 1u); break; } } } } while (0)
struct XcdBarrier { unsigned* bar; unsigned x; volatile LAS unsigned* st; };
__device__ __forceinline__ XcdBarrier xcd_barrier_post(unsigned* bar, volatile LAS unsigned* st) {
    XcdBarrier b; b.bar = bar; b.x = xb_xcc_id(); b.st = st;
    if (threadIdx.x == 0) (void)xb_add(&bar[XB_XCNT(b.x)], 1u);
    return b;
}
__device__ __forceinline__ void xcd_barrier_complete(unsigned* bar, unsigned x, unsigned& nloc, unsigned& nx) {
    const unsigned G = gridDim.x * gridDim.y * gridDim.z;
    unsigned sum, cnt, mine, sp = 0u;
    for (;;) {
        sum = 0u; cnt = 0u; mine = 0u;
#pragma unroll
        for (unsigned j = 0; j < 16; ++j) { const unsigned c = xb_ld(&bar[XB_XCNT(j)]); sum += c; cnt += (c > 0u) ? 1u : 0u; mine = (j == x) ? c : mine; }
        if (sum == G) break;
        __builtin_amdgcn_s_sleep(1);
        if ((++sp & 255u) == 0u) { if (xb_ld(&bar[XB_TMO])) break; if (sp > XB_SPIN_CAP) { atomicAdd(&bar[XB_TMO], 1u); break; } }
    }
    nloc = mine > 0u ? mine : 1u; nx = cnt > 0u ? cnt : 1u;
}
__device__ __forceinline__ void xcd_barrier(const XcdBarrier& b) {
    asm volatile("s_waitcnt vmcnt(0)" ::: "memory");
    __syncthreads();
    if (threadIdx.x == 0) {
        unsigned* bar = b.bar;
        __builtin_amdgcn_s_waitcnt(0);
        unsigned nloc = b.st[0], nx = b.st[1];
        if (nloc == 0u) { xcd_barrier_complete(bar, b.x, nloc, nx); b.st[0] = nloc; b.st[1] = nx; }
        const unsigned old = xb_add(&bar[XB_XSUB(b.x)], 1u);
        const unsigned gen = old / nloc;
        if (old + 1u == (gen + 1u) * nloc) {
            __builtin_amdgcn_fence(__ATOMIC_RELEASE, "agent");
            asm volatile("s_waitcnt vmcnt(0)" ::: "memory");
            const unsigned og = xb_add(&bar[XB_TOP], 1u);
            const unsigned tg = og / nx;
            if (og + 1u == (tg + 1u) * nx) xb_add(&bar[XB_TOPGEN], 1u);
            else XB_SPIN(xb_ld(&bar[XB_TOPGEN]) == tg, bar);
            __builtin_amdgcn_fence(__ATOMIC_ACQUIRE, "agent");
            xb_add(&bar[XB_XGEN(b.x)], 1u);
            asm volatile("s_waitcnt vmcnt(0)" ::: "memory");
        } else {
            XB_SPIN(xb_ld(&bar[XB_XGEN(b.x)]) == gen, bar);
            __builtin_amdgcn_fence(__ATOMIC_ACQUIRE, "agent");
            asm volatile("s_waitcnt vmcnt(0)" ::: "memory");
        }
    }
    __syncthreads();
}

__device__ const unsigned char kBucket[128] = {
    0, 1, 2, 3, 4, 5, 6, 7, 8, 9, 10, 11, 12, 13, 14, 15, 16, 16, 16, 17, 17, 18, 18, 18, 19, 19, 19, 20, 20, 20, 20, 21, 21, 21, 21, 22, 22, 22, 22, 22, 23, 23, 23, 23, 23, 23, 24, 24, 24, 24, 24, 24, 25, 25, 25, 25, 25, 25, 25, 26, 26, 26, 26, 26, 26, 26, 26, 27, 27, 27, 27, 27, 27, 27, 27, 27, 27, 28, 28, 28, 28, 28, 28, 28, 28, 28, 28, 29, 29, 29, 29, 29, 29, 29, 29, 29, 29, 29, 29, 30, 30, 30, 30, 30, 30, 30, 30, 30, 30, 30, 30, 30, 30, 31, 31, 31, 31, 31, 31, 31, 31, 31, 31, 31, 31, 31, 31, 31};

__device__ __forceinline__ void p0_transpose_item(const float* W, const float* gk, int K, int N, bf16* WT, LAS float* scr, int item, int lane, bool qscale = false, bool glu_rows = false) {
    const int nblk = N / 32, kb = item / nblk, nb = item % nblk, k0 = 64 * kb, n0 = 32 * nb;
    const float cs = (qscale && (n0 < 1024 || (n0 >= QS_OFF && n0 < KS_OFF))) ? 0.125f * 1.4426950408889634f : 1.0f;
#pragma unroll 8
    for (int i = 0; i < 32; ++i) { const int kk = 2 * i + (lane >> 5); float v = W[(size_t)(k0 + kk) * N + n0 + (lane & 31)]; if (gk) v *= gk[k0 + kk]; scr[kk * 33 + (lane & 31)] = v * cs; }
    LDS_WAIT(); asm volatile("" ::: "memory");
    const int c = lane & 7;
#pragma unroll
    for (int j = 0; j < 4; ++j) { const int n = (lane >> 3) + 8 * j; const LAS float* s = scr + (8 * c) * 33 + n;
        v4u o; o.x = pk2(s[0 * 33], s[1 * 33]); o.y = pk2(s[2 * 33], s[3 * 33]); o.z = pk2(s[4 * 33], s[5 * 33]); o.w = pk2(s[6 * 33], s[7 * 33]);
        int nrow = n0 + n; if (glu_rows) { const int hv = nrow >= DFF, n2 = hv ? nrow - DFF : nrow; nrow = 256 * (n2 >> 7) + 128 * hv + (n2 & 127); }
        *(GAS v4u*)(WT + (size_t)nrow * K + k0 + 8 * c) = o; }
    LDS_WAIT(); asm volatile("" ::: "memory");
}
__device__ __forceinline__ void row_cvt(const float* xrow, bf16* orow, float* rstd, int lane) {
    const f32x4* xr = (const f32x4*)xrow + lane;
    f32x4 v[8]; float s = 0.f;
#pragma unroll
    for (int j = 0; j < 8; ++j) { v[j] = xr[64 * j]; s += (v[j].x * v[j].x + v[j].y * v[j].y) + (v[j].z * v[j].z + v[j].w * v[j].w); }
    s = wave_sum(s);
    if (lane == 0) *rstd = 1.0f / sqrtf(s * (1.0f / DM) + EPS);
    unsigned long long* o8 = (unsigned long long*)orow + lane;
#pragma unroll
    for (int j = 0; j < 8; ++j) o8[64 * j] = (unsigned long long)pk2(v[j].x, v[j].y) | ((unsigned long long)pk2(v[j].z, v[j].w) << 32);
}

namespace att {
typedef short bf16x8 __attribute__((ext_vector_type(8)));
typedef short s16x4 __attribute__((ext_vector_type(4)));
typedef short v4i16_t __attribute__((ext_vector_type(4)));
typedef float f32x16 __attribute__((ext_vector_type(16)));
typedef unsigned u32x4 __attribute__((ext_vector_type(4)));
typedef float f32x2_t __attribute__((ext_vector_type(2))); typedef __bf16 bf16x2_t __attribute__((ext_vector_type(2)));
typedef LAS const char* lds_cptr;
constexpr float LOG2E = 1.4426950408889634f;
constexpr float QSCALE = 0.125f * LOG2E;
constexpr float SB_EXIT = 150.2f;
__device__ __forceinline__ int crow(int r, int hi) { return (r & 3) + 8 * (r >> 2) + 4 * hi; }
__device__ __forceinline__ unsigned cvtpk(float lo, float hi) { f32x2_t v = {lo, hi}; bf16x2_t b = __builtin_convertvector(v, bf16x2_t); return __builtin_bit_cast(unsigned, b); }
__device__ __forceinline__ s16x4 vtr(lds_cptr p) { return __builtin_bit_cast(s16x4, __builtin_amdgcn_ds_read_tr16_b64_v4i16((LAS v4i16_t*)p)); }
#define ATT_WAITV(n) asm volatile("s_waitcnt vmcnt(" #n ")" ::: "memory")
#define ATT_WAITL() asm volatile("s_waitcnt lgkmcnt(0)" ::: "memory")

__device__ __forceinline__ unsigned k_voff(int lane, int odd) { const int sw = (lane >> 4) + 4 * odd, c = (lane & 7) ^ sw; return (unsigned)((lane >> 3) * DIN * 2 + c * 16); }
__device__ __forceinline__ void dma_k(const bf16* src, LAS unsigned char* kreg, unsigned vk0, unsigned vk1) {
#pragma unroll
    for (int i = 0; i < 8; ++i) { const char* ub = (const char*)src + (size_t)i * (8 * DIN * 2);
        __builtin_amdgcn_global_load_lds((const unsigned*)(ub + ((i & 1) ? vk1 : vk0)), (LAS unsigned*)(kreg + i * 1024), 16, 0, 0); }
}
__device__ __forceinline__ unsigned v_voff(int lane) { return (unsigned)((lane >> 2) * DIN * 2 + (lane & 3) * 16); }
__device__ __forceinline__ void dma_v(const bf16* src, LAS unsigned char* vreg, unsigned vv) {
#pragma unroll
    for (int p = 0; p < 8; ++p) { const char* ub = (const char*)src + (size_t)(p & 3) * (16 * DIN * 2) + (p >> 2) * 64;
        __builtin_amdgcn_global_load_lds((const unsigned*)(ub + vv), (LAS unsigned*)(vreg + p * 1024), 16, 0, 0); }
}
__device__ __forceinline__ void load_kf(bf16x8 (&kf)[8], lds_cptr kreg, int r32, int hi) {
    const lds_cptr kp = kreg + r32 * 128; const int sw = (r32 >> 1) & 7;
#pragma unroll
    for (int d0 = 0; d0 < 4; ++d0) { const int off = ((2 * d0 + hi) ^ sw) * 16;
        kf[2 * d0] = *(const LAS bf16x8*)(kp + off); kf[2 * d0 + 1] = *(const LAS bf16x8*)(kp + 4096 + off); }
}
__device__ __forceinline__ void qkt(f32x16& p0, f32x16& p1, const bf16x8 (&kf)[8], const bf16x8 (&qr)[4]) {
    const f32x16 z = {};
    p0 = __builtin_amdgcn_mfma_f32_32x32x16_bf16(kf[0], qr[0], z, 0, 0, 0); p1 = __builtin_amdgcn_mfma_f32_32x32x16_bf16(kf[1], qr[0], z, 0, 0, 0);
#pragma unroll
    for (int d0 = 1; d0 < 4; ++d0) { p0 = __builtin_amdgcn_mfma_f32_32x32x16_bf16(kf[2 * d0], qr[d0], p0, 0, 0, 0); p1 = __builtin_amdgcn_mfma_f32_32x32x16_bf16(kf[2 * d0 + 1], qr[d0], p1, 0, 0, 0); }
}
__device__ __forceinline__ void pv(f32x16 (&o)[2], lds_cptr vp0, const f32x16& p0, const f32x16& p1) {
    u32x4 pw[4];
#pragma unroll
    for (int j = 0; j < 4; ++j) { pw[0][j] = cvtpk(p0[2 * j], p0[2 * j + 1]); pw[1][j] = cvtpk(p0[8 + 2 * j], p0[9 + 2 * j]); pw[2][j] = cvtpk(p1[2 * j], p1[2 * j + 1]); pw[3][j] = cvtpk(p1[8 + 2 * j], p1[9 + 2 * j]); }
#pragma unroll
    for (int d0 = 0; d0 < 2; ++d0)
#pragma unroll
        for (int ks = 0; ks < 4; ++ks) { const s16x4 lo = vtr(vp0 + d0 * 4096 + ks * 1024), hi4 = vtr(vp0 + d0 * 4096 + ks * 1024 + 512);
            const bf16x8 vf = (bf16x8){lo[0], lo[1], lo[2], lo[3], hi4[0], hi4[1], hi4[2], hi4[3]};
            o[d0] = __builtin_amdgcn_mfma_f32_32x32x16_bf16(__builtin_bit_cast(bf16x8, pw[ks]), vf, o[d0], 0, 0, 0); }
}
__device__ __forceinline__ float swap_other(float v) { auto rr = __builtin_amdgcn_permlane32_swap(__float_as_uint(v), __float_as_uint(v), false, false); return (threadIdx.x & 32) ? __uint_as_float(rr[0]) : __uint_as_float(rr[1]); }

template <bool SCALE> __device__ __forceinline__ void store_o(const f32x16 (&o)[2], LAS unsigned char* kreg, LAS float* wsf, bf16* y, float* slots, int tok0, int col0, int slot, int lane) {
    const int r32 = lane & 31, hi = lane >> 5;
    LAS float* stg = (LAS float*)kreg;
#pragma unroll
    for (int r = 0; r < 16; ++r) { const int row = crow(r, hi); stg[row * 64 + r32] = o[0][r]; stg[row * 64 + 32 + r32] = o[1][r]; }
    ATT_WAITL();
#pragma unroll
    for (int i = 0; i < 4; ++i) { const int row = i * 8 + (lane >> 3), ch = lane & 7;
        const f32x4 a = *(const LAS f32x4*)(stg + row * 64 + ch * 8), b = *(const LAS f32x4*)(stg + row * 64 + ch * 8 + 4);
        const float s = SCALE ? wsf[32 + row] : 1.0f;
        const f32x4 a2 = a * s, b2 = b * s;
        float ss = ((a2[0] * a2[0] + a2[1] * a2[1]) + (a2[2] * a2[2] + a2[3] * a2[3])) + ((b2[0] * b2[0] + b2[1] * b2[1]) + (b2[2] * b2[2] + b2[3] * b2[3]));
        ss += __shfl_xor(ss, 1); ss += __shfl_xor(ss, 2); ss += __shfl_xor(ss, 4);
        v4u w; w.x = cvtpk(a2[0], a2[1]); w.y = cvtpk(a2[2], a2[3]); w.z = cvtpk(b2[0], b2[1]); w.w = cvtpk(b2[2], b2[3]);
        *(GAS v4u*)(y + (size_t)(tok0 + row) * DM + col0 + ch * 8) = w;
        if (ch == 0) *(GAS float*)(slots + (size_t)(tok0 + row) * 32 + slot) = ss; }
    ATT_WAITL();
}

__device__ __forceinline__ void swa_item(const bf16* proj, LAS unsigned char* kreg, LAS unsigned char* vreg, LAS float* wsf, const LAS float* tab, float sink2, bf16* y, float* slots, int h, int q0, int lane) {
    const int r32 = lane & 31, hi = lane >> 5, kvh = h >> 3;
    const bf16* Kb = proj + KA_OFF + kvh * HD; const bf16* Vb = proj + VA_OFF + kvh * HD;
    const int kt_hi = q0 >> 6; int kt = kt_hi - 2 < 0 ? 0 : kt_hi - 2;
    const unsigned vk0 = k_voff(lane, 0), vk1 = k_voff(lane, 1), vv = v_voff(lane);
    dma_k(Kb + (size_t)kt * 64 * DIN, kreg, vk0, vk1); dma_v(Vb + (size_t)kt * 64 * DIN, vreg, vv);
    bf16x8 qr[4];
#pragma unroll
    for (int d0 = 0; d0 < 4; ++d0) qr[d0] = *(const GAS bf16x8*)(proj + (size_t)(q0 + r32) * DIN + QA_OFF + h * HD + d0 * 16 + hi * 8);
    const lds_cptr vp0 = (lds_cptr)vreg + ((lane >> 4) & 1) * 32 + (lane & 3) * 8 + (4 * hi + ((lane & 15) >> 2)) * 64;
    f32x16 o[2]; o[0] = f32x16{}; o[1] = f32x16{};
    float m = sink2, l = hi ? 0.f : 1.0f;
    const LAS float* tb = tab + h * 256;
    for (;; ++kt) {
        const bool more = kt < kt_hi;
        ATT_WAITV(8);
        bf16x8 kf[8]; load_kf(kf, (lds_cptr)kreg, r32, hi); ATT_WAITL();
        if (more) dma_k(Kb + (size_t)(kt + 1) * 64 * DIN, kreg, vk0, vk1);
        f32x16 p0, p1; qkt(p0, p1, kf, qr);
        const LAS float* t0 = tb + (191 - (q0 + r32 - 64 * kt - 4 * hi));
#pragma unroll
        for (int r = 0; r < 16; ++r) { const int cr = (r & 3) + 8 * (r >> 2); p0[r] += t0[cr]; p1[r] += t0[32 + cr]; }
        float rm = fmaxf(p0[0], p1[0]);
#pragma unroll
        for (int r = 1; r < 16; ++r) rm = fmaxf(rm, fmaxf(p0[r], p1[r]));
        rm = fmaxf(rm, swap_other(rm));
        const float mn = fmaxf(m, rm), f = __builtin_amdgcn_exp2f(m - mn); m = mn;
        float ps = 0.f;
#pragma unroll
        for (int r = 0; r < 16; ++r) { p0[r] = __builtin_amdgcn_exp2f(p0[r] - mn); p1[r] = __builtin_amdgcn_exp2f(p1[r] - mn); ps += p0[r] + p1[r]; }
        l = l * f + ps;
        if (__any(f != 1.0f)) {
            if (hi == 0) wsf[r32] = f;
            ATT_WAITL();
#pragma unroll
            for (int r = 0; r < 16; ++r) { const float fr_ = wsf[crow(r, hi)]; o[0][r] *= fr_; o[1][r] *= fr_; }
            ATT_WAITL();
        }
        if (more) ATT_WAITV(8); else ATT_WAITV(0);
        pv(o, vp0, p0, p1); ATT_WAITL();
        if (!more) break;
        dma_v(Vb + (size_t)(kt + 1) * 64 * DIN, vreg, vv);
    }
    l += swap_other(l);
    if (hi == 0) wsf[32 + r32] = 1.0f / l;
    ATT_WAITL();
    store_o<true>(o, kreg, wsf, y, slots, q0, h * HD, h, lane);
}

__device__ __forceinline__ void sb_item(const bf16* proj, LAS unsigned char* kreg, LAS unsigned char* vreg, bf16* y, float* slots, int h, int q0, int lane) {
    const int r32 = lane & 31, hi = lane >> 5;
    const bf16* Kb = proj + KS_OFF + h * HD; const bf16* Vb = proj + VS_OFF + h * HD;
    int kt = q0 >> 6;
    const unsigned vk0 = k_voff(lane, 0), vk1 = k_voff(lane, 1), vv = v_voff(lane);
    dma_k(Kb + (size_t)kt * 64 * DIN, kreg, vk0, vk1); dma_v(Vb + (size_t)kt * 64 * DIN, vreg, vv);
    bf16x8 qr[4];
#pragma unroll
    for (int d0 = 0; d0 < 4; ++d0) qr[d0] = *(const GAS bf16x8*)(proj + (size_t)(q0 + r32) * DIN + QS_OFF + h * HD + d0 * 16 + hi * 8);
    const lds_cptr vp0 = (lds_cptr)vreg + ((lane >> 4) & 1) * 32 + (lane & 3) * 8 + (4 * hi + ((lane & 15) >> 2)) * 64;
    f32x16 o[2]; o[0] = f32x16{}; o[1] = f32x16{};
    float R = 0.f;
    bool diag = true;
    for (;; --kt) {
        const bool more = kt > 0;
        ATT_WAITV(8);
        bf16x8 kf[8]; load_kf(kf, (lds_cptr)kreg, r32, hi); ATT_WAITL();
        if (more) dma_k(Kb + (size_t)(kt - 1) * 64 * DIN, kreg, vk0, vk1);
        f32x16 p0, p1; qkt(p0, p1, kf, qr);
        const int qrel = diag ? (q0 + r32 - 64 * kt - 4 * hi) : 1000;
        f32x16 e0, e1; float T[2][4];
#pragma unroll
        for (int r = 0; r < 16; ++r) { const int cr = (r & 3) + 8 * (r >> 2);
            float s0 = fmaxf(p0[r], 0.f) + __builtin_amdgcn_logf(1.0f + __builtin_amdgcn_exp2f(-fabsf(p0[r])));
            float s1 = fmaxf(p1[r], 0.f) + __builtin_amdgcn_logf(1.0f + __builtin_amdgcn_exp2f(-fabsf(p1[r])));
            e0[r] = (cr < qrel) ? s0 : 0.f; e1[r] = (cr + 32 < qrel) ? s1 : 0.f; }
#pragma unroll
        for (int w = 0; w < 4; ++w) { e0[4 * w + 2] += e0[4 * w + 3]; e0[4 * w + 1] += e0[4 * w + 2]; e0[4 * w] += e0[4 * w + 1]; T[0][w] = e0[4 * w];
                                      e1[4 * w + 2] += e1[4 * w + 3]; e1[4 * w + 1] += e1[4 * w + 2]; e1[4 * w] += e1[4 * w + 1]; T[1][w] = e1[4 * w]; }
        float run = R, base[2][4];
#pragma unroll
        for (int u = 1; u >= 0; --u)
#pragma unroll
            for (int w = 3; w >= 0; --w) { const float tp = swap_other(T[u][w]); const float rp = run + tp; base[u][w] = hi ? run : rp; run = rp + T[u][w]; }
#pragma unroll
        for (int r = 0; r < 16; ++r) { const int cr = (r & 3) + 8 * (r >> 2);
            const float a0 = __builtin_amdgcn_exp2f((p0[r] - base[0][r >> 2]) - e0[r]), a1 = __builtin_amdgcn_exp2f((p1[r] - base[1][r >> 2]) - e1[r]);
            p0[r] = (cr < qrel) ? a0 : 0.f; p1[r] = (cr + 32 < qrel) ? a1 : 0.f; }
        R = run;
        if (more) ATT_WAITV(8); else ATT_WAITV(0);
        pv(o, vp0, p0, p1); ATT_WAITL();
        if (!more || __all(R >= SB_EXIT)) break;
        dma_v(Vb + (size_t)(kt - 1) * 64 * DIN, vreg, vv);
        diag = false;
    }
    ATT_WAITV(0);
    store_o<false>(o, kreg, nullptr, y, slots, q0, 1024 + h * HD, 16 + h, lane);
}
#undef ATT_WAITV
#undef ATT_WAITL
}

struct Args { const float* in[14]; float* out; unsigned char* ws; };
__global__ void __launch_bounds__(NWAVES * 64, 2) mk_fwd(Args args) {
    extern __shared__ __attribute__((aligned(16))) unsigned char lds_raw[];
    LAS unsigned char* lds = (LAS unsigned char*)lds_raw;
    volatile LAS unsigned* MISC = (volatile LAS unsigned*)(lds + MISC_OFF);
    const int tid = threadIdx.x;
    const int G = gridDim.x; const int bx = blockIdx.x; const int vcu = (G % 8 == 0) ? (bx % 8) * (G / 8) + bx / 8 : bx;
    unsigned char* ws = args.ws;
    unsigned* ctl = (unsigned*)(ws + WS_CTL);
    const float* x = args.in[0]; const float* w_in = args.in[1]; const float* g_attn = args.in[2]; const float* rel_bias = args.in[3];
    const float* sinks = args.in[4]; const float* g_swa = args.in[5]; const float* g_sb = args.in[6]; const float* w_out = args.in[7];
    const float* g_mlp = args.in[8]; const float* w_up = args.in[9]; const float* w_conv = args.in[10]; const float* b_conv = args.in[11];
    const float* w_down = args.in[12]; const float* g_final = args.in[13];
    float* out = args.out;
    float* rstd1 = (float*)(ws + WS_RSTD1); float* ss2 = (float*)(ws + WS_SS2); float* ss3 = (float*)(ws + WS_SS3);
    bf16* WinT = (bf16*)(ws + WS_WIN); bf16* WoutT = (bf16*)(ws + WS_WOUT); bf16* WupT = (bf16*)(ws + WS_WUP); bf16* WdownT = (bf16*)(ws + WS_WDOWN);
    bf16* xb = (bf16*)(ws + WS_XB); bf16* proj = (bf16*)(ws + WS_PROJ); bf16* mix = (bf16*)(ws + WS_MIX);
    float* ssY = (float*)(ws + WS_SSY);
    bf16* act = (bf16*)(ws + WS_ACT); float* GFb = (float*)(ws + WS_GF); float* VFb = (float*)(ws + WS_VF); float* GLb = (float*)(ws + WS_GL);

    for (int u = tid; u < (LDS_BYTES - LDSCTL_OFF) / 4; u += NWAVES * 64) ((LAS unsigned*)(lds + LDSCTL_OFF))[u] = 0u;
    __syncthreads();
    XcdBarrier bar = xcd_barrier_post(ctl + CW_BAR, MISC + 8);
    const int NGW = G * NWAVES, NGT = G * NWAVES * 64;
#define PHASE_IDS() int tidp = threadIdx.x; asm volatile("" : "+v"(tidp)); const int lane = tidp & 63, wave = __builtin_amdgcn_readfirstlane(tidp >> 6); const int gw = vcu * NWAVES + wave, gt = vcu * (NWAVES * 64) + tidp; (void)lane; (void)gw; (void)gt

#if defined(PROBE_A)
    unsigned long long ts_[12]; int nts_ = 0;
#define STAMP() do { ts_[nts_++] = __builtin_amdgcn_s_memrealtime(); } while (0)
#else
#define STAMP() do { } while (0)
#endif
    STAMP();
#ifndef REP_P0
#define REP_P0 1
#endif
    for (int rep0 = 0; rep0 < REP_P0; ++rep0) {
    {
        PHASE_IDS();
        LAS float* scr = (LAS float*)(lds + wave * 16384);
        constexpr int I_IN = (DM / 64) * (DIN / 32), I_OUT = (DM / 64) * (DM / 32), I_UP = (DM / 64) * (2 * DFF / 32), I_DOWN = (DFF / 64) * (DM / 32);
        constexpr int NITEMS = I_IN + I_OUT + I_UP + I_DOWN;
        for (int it = gw; it < NITEMS; it += NGW) {
            int r = it;
            if (r < I_IN) { p0_transpose_item(w_in, g_attn, DM, DIN, WinT, scr, r, lane, true); continue; } r -= I_IN;
            if (r < I_OUT) { p0_transpose_item(w_out, nullptr, DM, DM, WoutT, scr, r, lane); continue; } r -= I_OUT;
            if (r < I_UP) { p0_transpose_item(w_up, g_mlp, DM, 2 * DFF, WupT, scr, r, lane, false, true); continue; } r -= I_UP;
            p0_transpose_item(w_down, nullptr, DFF, DM, WdownT, scr, r, lane);
        }
        for (int m = gw; m < M; m += NGW) row_cvt(x + (size_t)m * DM, xb + (size_t)m * DM, rstd1 + m, lane);
    }
    xcd_barrier(bar); STAMP();
    }

#ifndef REP_P1
#define REP_P0 1
#define REP_P1 1
#define REP_P2 1
#define REP_P4 1
#endif
    for (int rep = 0; rep < REP_P1; ++rep) {
    {
        pg8::Gemm g{xb, WinT, M, DIN, DM}; pg8::StaticOrder S; S.init(M, DIN, G, bx);
        pg8::EpiRowScaleBf16 E{proj, proj, DIN, 1 << 30, rstd1, nullptr};
        pg8::gemm_phase<pg8::EpiRowScaleBf16, pg8::StaticOrder, true, true>(lds, g, S, E);
    }
    xcd_barrier(bar); STAMP();
    }

    for (int rep = 0; rep < REP_P2; ++rep) {
    {
        PHASE_IDS();
        LAS float* tab = (LAS float*)(lds + ATT_TAB_OFF);
        for (int i = tidp; i < 16 * 256; i += NWAVES * 64) { const int h = i >> 8, dist = 191 - (i & 255);
            tab[i] = (dist >= 0 && dist < 128) ? rel_bias[kBucket[dist] * 16 + h] * att::LOG2E : -1e30f; }
        __syncthreads();
        LAS unsigned char* kreg = lds + wave * 16384; LAS unsigned char* vreg = kreg + 8192; LAS float* wsf = (LAS float*)(lds + ATT_WSF_OFF) + wave * 64;
        for (int tb = vcu; tb < M / 64; tb += G) {
            const int q0 = 64 * tb + 32 * (wave & 1);
            for (int hh = 0; hh < 4; ++hh) { const int h = 4 * (wave >> 1) + hh; att::swa_item(proj, kreg, vreg, wsf, tab, sinks[h] * att::LOG2E, mix, ssY, h, q0, lane); }
            for (int hh = 0; hh < 4; ++hh) { const int h = 4 * (wave >> 1) + hh; att::sb_item(proj, kreg, vreg, mix, ssY, h, q0, lane); }
        }
    }
    xcd_barrier(bar); STAMP();
    }

    { PHASE_IDS();
    for (int m = gw; m < M; m += NGW) {
        float s = (lane < 32) ? ssY[(size_t)m * 32 + lane] : 0.f;
        s += __shfl_xor(s, 1); s += __shfl_xor(s, 2); s += __shfl_xor(s, 4); s += __shfl_xor(s, 8);
        const float rA = 1.0f / sqrtf(__shfl(s, 0) * (1.0f / 1024) + EPS), rB = 1.0f / sqrtf(__shfl(s, 16) * (1.0f / 1024) + EPS);
        v4u* yr = (v4u*)(mix + (size_t)m * DM) + lane;
#pragma unroll
        for (int j = 0; j < 4; ++j) { const v4u v = yr[64 * j]; const int c = (lane + 64 * j) * 8; const float r = j < 2 ? rA : rB; const float* gp = (j < 2 ? g_swa + c : g_sb + (c - 1024));
            const f32x4 g0 = *(const f32x4*)gp, g1 = *(const f32x4*)(gp + 4);
            v4u o; o.x = pk2(bf2f(v.x & 0xffffu) * r * g0[0], bf2f(v.x >> 16) * r * g0[1]); o.y = pk2(bf2f(v.y & 0xffffu) * r * g0[2], bf2f(v.y >> 16) * r * g0[3]);
            o.z = pk2(bf2f(v.z & 0xffffu) * r * g1[0], bf2f(v.z >> 16) * r * g1[1]); o.w = pk2(bf2f(v.w & 0xffffu) * r * g1[2], bf2f(v.w >> 16) * r * g1[3]);
            yr[64 * j] = o; }
    } }
    xcd_barrier(bar); STAMP();

    {
        pg8::Gemm g{mix, WoutT, M, DM, DM}; pg8::StaticOrder S; S.init(M, DM, G, bx);
        pg8::EpiResidual E{x, out, xb, DM, ss2};
        pg8::gemm_phase<pg8::EpiResidual, pg8::StaticOrder, true, true>(lds, g, S, E);
    }
    xcd_barrier(bar); STAMP();

    for (int rep = 0; rep < REP_P4; ++rep) {
    {
        pg8::Gemm g{xb, WupT, M, 2 * DFF, DM}; pg8::StaticOrder S; S.init(M, 2 * DFF, G, bx);
        pg8::EpiConvGlu E{act, DFF, ss2, w_conv, b_conv, GFb, VFb, GLb};
        pg8::gemm_phase<pg8::EpiConvGlu, pg8::StaticOrder, true, true>(lds, g, S, E);
    }
    xcd_barrier(bar); STAMP();
    }

    { PHASE_IDS();
    for (int i = gt; i < (M / 64) * 2 * (DFF / 4); i += NGT) {
        const int c = (i % (DFF / 4)) * 4, gi = i / (DFF / 4), Gg = gi >> 1, ri = gi & 1;
        const f32x4 z = (f32x4){0.f, 0.f, 0.f, 0.f};
        const f32x4 gv = *(const f32x4*)(GFb + ((size_t)Gg * 2 + ri) * DFF + c), vv = *(const f32x4*)(VFb + ((size_t)Gg * 2 + ri) * DFF + c);
        const f32x4 l1 = Gg > 0 ? *(const f32x4*)(GLb + ((size_t)(Gg - 1) * 2 + 1) * DFF + c) : z, l0 = Gg > 0 ? *(const f32x4*)(GLb + ((size_t)(Gg - 1) * 2 + 0) * DFF + c) : z;
        const f32x4 g1 = ri ? *(const f32x4*)(GFb + ((size_t)Gg * 2) * DFF + c) : l1, g2 = ri ? l1 : l0;
        const f32x4 w0 = *(const f32x4*)(w_conv + c), w1 = *(const f32x4*)(w_conv + DFF + c), w2 = *(const f32x4*)(w_conv + 2 * DFF + c), bb = *(const f32x4*)(b_conv + c);
        float o[4];
#pragma unroll
        for (int j = 0; j < 4; ++j) o[j] = pg8::silu_mul(bb[j] + w0[j] * g2[j] + w1[j] * g1[j] + w2[j] * gv[j], vv[j]);
        *(unsigned long long*)(act + (size_t)(Gg * 64 + ri) * DFF + c) = (unsigned long long)pk2(o[0], o[1]) | ((unsigned long long)pk2(o[2], o[3]) << 32);
    } }
    xcd_barrier(bar); STAMP();

    {
        pg8::Gemm g{act, WdownT, M, DM, DFF}; pg8::StaticOrder S; S.init(M, DM, G, bx);
        pg8::EpiResidual E{out, out, nullptr, DM, ss3};
        pg8::gemm_phase<pg8::EpiResidual, pg8::StaticOrder, true, true>(lds, g, S, E);
    }
    xcd_barrier(bar); STAMP();

    {
        PHASE_IDS();
        const unsigned tmo = xb_ld(ctl + CW_BAR + XB_TMO);
        for (int m = gw; m < M; m += NGW) {
            float s = (lane < 32) ? ss3[(size_t)m * 32 + lane] : 0.f; s = wave_sum(s);
            float r = 1.0f / sqrtf(s * (1.0f / DM) + EPS);
            if (tmo) r = __builtin_nanf("");
            f32x4* xr = (f32x4*)(out + (size_t)m * DM) + lane; const f32x4* gr = (const f32x4*)g_final + lane;
#pragma unroll
            for (int j = 0; j < 8; ++j) { const f32x4 v = xr[64 * j]; xr[64 * j] = v * r * gr[64 * j]; }
        }
    }
#if defined(PROBE_A)
    xcd_barrier(bar); STAMP();
    if (blockIdx.x == 0) {
        const float d1 = (float)(ts_[PROBE_A2] - ts_[PROBE_A]) * 0.01f, d2 = (float)(ts_[PROBE_B2] - ts_[PROBE_B]) * 0.01f;
        if (threadIdx.x == 0) out[0] += d1;
        for (int i = threadIdx.x; i < (1 << 20); i += NWAVES * 64) out[4096 + i] += d2;
    }
#endif
}

extern "C" void kernel_launch(void* const* d_in, const int* in_sizes, int n_in, void* d_out, int out_size, void* d_ws, size_t ws_size, hipStream_t stream) {
    static int grid = 0;
    if (grid == 0) {
        if (n_in != 14 || out_size != M * DM || ws_size < WS_END) { fprintf(stderr, "kernel_launch: unexpected shapes (n_in %d out %d ws %zu)\n", n_in, out_size, ws_size); grid = -1; return; }
        int dev = 0, cus = 0, per_cu = 0;
        if (hipGetDevice(&dev) != hipSuccess || hipDeviceGetAttribute(&cus, hipDeviceAttributeMultiprocessorCount, dev) != hipSuccess) { grid = -1; return; }
        if (hipFuncSetAttribute((const void*)mk_fwd, hipFuncAttributeMaxDynamicSharedMemorySize, LDS_BYTES) != hipSuccess) { fprintf(stderr, "kernel_launch: hipFuncSetAttribute failed\n"); grid = -1; return; }
        if (hipOccupancyMaxActiveBlocksPerMultiprocessor(&per_cu, (const void*)mk_fwd, NWAVES * 64, LDS_BYTES) != hipSuccess || per_cu < 1) { fprintf(stderr, "kernel_launch: occupancy query reports %d\n", per_cu); }
        (void)hipGetLastError();
        grid = cus;
    }
    if (grid < 0) return;
    if (hipMemsetAsync((char*)d_ws + WS_CTL, 0, CTL_ZERO_BYTES, stream) != hipSuccess) return;
    Args a{};
    for (int i = 0; i < 14; ++i) a.in[i] = (const float*)d_in[i];
    a.out = (float*)d_out; a.ws = (unsigned char*)d_ws;
    hipLaunchKernelGGL(mk_fwd, dim3(grid), dim3(NWAVES * 64), LDS_BYTES, stream, a);
}
```

```cpp
#include <hip/hip_runtime.h>
#include <cstdint>
#include <cstdio>

namespace pg8 {
#define PG8_LAS __attribute__((address_space(3)))
#define PG8_GAS __attribute__((address_space(1)))
typedef unsigned short bf16_t;
typedef short bf16x8 __attribute__((ext_vector_type(8)));
typedef float f32x4 __attribute__((ext_vector_type(4)));
typedef unsigned u32x4 __attribute__((ext_vector_type(4)));
typedef unsigned u32x2 __attribute__((ext_vector_type(2)));
constexpr int BM = 256, BK = 64, HALF = 128, HTB = HALF * BK * 2  , STAGE_BYTES = 8 * HTB, NXCD = 8, WGM = 8;

__host__ __device__ __forceinline__ int lds_byte(int r, int c) { const int st = (r >> 4) * 2 + (c >> 5), rr = r & 15, cc = c & 31, ob = rr * 64 + cc * 2; return st * 1024 + (ob ^ (((ob >> 9) & 1) << 5)); }
__host__ __device__ __forceinline__ void stage_rc(int b, int& R, int& C) { const int st = b / 1024, sb = b % 1024, swz = sb ^ (((sb >> 9) & 1) << 5); R = (st >> 1) * 16 + swz / 64; C = (st & 1) * 32 + (swz % 64) / 2; }
__host__ __device__ __forceinline__ int perm32(int rho) { const int n = rho >> 4, i = rho & 15; return 8 * (i >> 2) + 4 * n + (i & 3); }

struct Unit { int pm, pn, idx; };
struct Gemm { const bf16_t* A; const bf16_t* Bt; int M, N, K; };

struct StaticOrder {
    int nM, nN, nwg, G, c;
    __host__ __device__ void init(int M, int N, int G_, int c_) { nM = M / BM; nN = N / BM; nwg = nM * nN; G = G_; c = c_; }
    __host__ __device__ bool next(int i, Unit& u) const {
        const long L = (long)i * G + c; if (L >= nwg) return false;
        int wgid = (int)L; { const int q = nwg / NXCD, r = nwg % NXCD, xcd = wgid % NXCD, off = wgid / NXCD; wgid = (xcd < r ? xcd * (q + 1) : r * (q + 1) + (xcd - r) * q) + off; }
        const int nig = WGM * nN, gid = wgid / nig, fm = gid * WGM, gsz = (nM - fm) < WGM ? (nM - fm) : WGM;
        u.pm = fm + ((wgid % nig) % gsz); u.pn = (wgid % nig) / gsz; u.idx = i; return true;
    }
    __device__ __forceinline__ void a_ready(const Unit&) const {}
    __device__ __forceinline__ void done(const Unit&) const {}
};

__device__ __forceinline__ unsigned cvt_pk_bf16(float lo, float hi) { unsigned r; asm volatile("v_cvt_pk_bf16_f32 %0, %1, %2" : "=v"(r) : "v"(lo), "v"(hi)); return r; }

struct EpiRowScaleBf16 {
    static constexpr bool PERM = true, AFTER_DRAIN = false, MIDSCALE = false;
    bf16_t* O; bf16_t* O2; int ldc; int split_pn; const float* rs; const float* slots;
    __device__ __forceinline__ void operator()(const f32x4 (&acc)[2][2][4][2], const Unit& u, int wr, int wc, int fr, int fq) const {
        const int row0 = u.pm * BM + wr * 64 + fr; int pn = u.pn; bf16_t* base = O;
        if (pn >= split_pn) { pn -= split_pn; base = O2; }
        const int col0 = pn * BM + wc * 32 + 8 * fq;
        float sc[2][4];
#pragma unroll
        for (int ai = 0; ai < 2; ++ai)
#pragma unroll
            for (int m = 0; m < 4; ++m) {
                const int r = row0 + ai * HALF + m * 16;
                if (rs) sc[ai][m] = *(const PG8_GAS float*)(rs + r);
                else { const PG8_GAS f32x4* sp = (const PG8_GAS f32x4*)(slots + (size_t)r * 32 + fq * 8); const f32x4 a = sp[0], b = sp[1];
                    float s = ((a[0] + a[1]) + (a[2] + a[3])) + ((b[0] + b[1]) + (b[2] + b[3])); s += __shfl_xor(s, 16); s += __shfl_xor(s, 32);
                    sc[ai][m] = 1.0f / sqrtf(s * (1.0f / 2048.0f) + 1e-6f); }
            }
#pragma unroll
        for (int ai = 0; ai < 2; ++ai)
#pragma unroll
            for (int m = 0; m < 4; ++m) { bf16_t* rowp = base + (size_t)(row0 + ai * HALF + m * 16) * ldc + col0; const float s = sc[ai][m];
#pragma unroll
                for (int bj = 0; bj < 2; ++bj) { const f32x4 v0 = acc[ai][bj][m][0] * s, v1 = acc[ai][bj][m][1] * s;
                    u32x4 w; w.x = cvt_pk_bf16(v0[0], v0[1]); w.y = cvt_pk_bf16(v0[2], v0[3]); w.z = cvt_pk_bf16(v1[0], v1[1]); w.w = cvt_pk_bf16(v1[2], v1[3]);
                    *(u32x4*)(rowp + bj * HALF) = w; } }
    }
};
struct EpiResidual {
    static constexpr bool PERM = false, AFTER_DRAIN = false, MIDSCALE = false;
    const float* base; float* out; bf16_t* ob; int ldc; float* slots;
    __device__ __forceinline__ void operator()(const f32x4 (&acc)[2][2][4][2], const Unit& u, int wr, int wc, int fr, int fq) const {
        const int row0 = u.pm * BM + wr * 64 + fr, col0 = u.pn * BM + wc * 32 + 4 * fq;
#pragma unroll
        for (int ai = 0; ai < 2; ++ai)
#pragma unroll
            for (int m = 0; m < 4; ++m) { const int r = row0 + ai * HALF + m * 16; const size_t off = (size_t)r * ldc + col0; float ss = 0.f;
#pragma unroll
                for (int bj = 0; bj < 2; ++bj)
#pragma unroll
                    for (int n = 0; n < 2; ++n) { const f32x4 v = *(const f32x4*)(base + off + bj * HALF + n * 16) + acc[ai][bj][m][n];
                        *(f32x4*)(out + off + bj * HALF + n * 16) = v; ss += (v[0] * v[0] + v[1] * v[1]) + (v[2] * v[2] + v[3] * v[3]);
                        if (ob) { u32x2 w; w.x = cvt_pk_bf16(v[0], v[1]); w.y = cvt_pk_bf16(v[2], v[3]); *(u32x2*)(ob + off + bj * HALF + n * 16) = w; } }
                ss += __shfl_xor(ss, 16); ss += __shfl_xor(ss, 32);
                if (fq == 0) slots[(size_t)r * 32 + u.pn * 4 + wc] = ss; }
    }
};

struct MixOrder : StaticOrder {
    const float* ssY; PG8_LAS float* tab;
    __device__ __forceinline__ void a_ready(const Unit& u) const {
        int tid = threadIdx.x; asm volatile("" : "+v"(tid));
        const int row = tid >> 1, grp = tid & 1;
        const PG8_GAS f32x4* sp = (const PG8_GAS f32x4*)(ssY + (size_t)(u.pm * BM + row) * 32 + grp * 16); const f32x4 a = sp[0], b = sp[1], c = sp[2], d = sp[3];
        const float s = (((a[0] + a[1]) + (a[2] + a[3])) + ((b[0] + b[1]) + (b[2] + b[3]))) + (((c[0] + c[1]) + (c[2] + c[3])) + ((d[0] + d[1]) + (d[2] + d[3])));
        const float o = __shfl_xor(s, 1), sA = grp ? o : s, sB = grp ? s : o;
        const float vA = sA * (1.0f / 1024.0f) + 1e-6f, vB = sB * (1.0f / 1024.0f) + 1e-6f;
        tab[(u.idx & 1) * 512 + tid] = grp ? 1.0f / sqrtf(vB) : sqrtf(vB / vA);
    }
};
struct EpiResidualMix {
    static constexpr bool PERM = false, AFTER_DRAIN = false, MIDSCALE = true;
    const float* base; float* out; bf16_t* ob; int ldc; float* slots; const PG8_LAS float* tab;
    __device__ __forceinline__ void midscale(f32x4 (&acc)[2][2][4][2], const Unit& u, int wr, int wc, int fr, int fq) const {
        const PG8_LAS float* t = tab + (u.idx & 1) * 512 + (wr * 64 + fr) * 2;
#pragma unroll
        for (int ai = 0; ai < 2; ++ai)
#pragma unroll
            for (int m = 0; m < 4; ++m) { const float ratio = t[(ai * HALF + m * 16) * 2];
#pragma unroll
                for (int bj = 0; bj < 2; ++bj)
#pragma unroll
                    for (int n = 0; n < 2; ++n) acc[ai][bj][m][n] *= ratio; }
    }
    __device__ __forceinline__ void operator()(const f32x4 (&acc)[2][2][4][2], const Unit& u, int wr, int wc, int fr, int fq) const {
        const int row0 = u.pm * BM + wr * 64 + fr, col0 = u.pn * BM + wc * 32 + 4 * fq;
        const PG8_LAS float* t = tab + (u.idx & 1) * 512 + (wr * 64 + fr) * 2 + 1;
#pragma unroll
        for (int ai = 0; ai < 2; ++ai)
#pragma unroll
            for (int m = 0; m < 4; ++m) { const int r = row0 + ai * HALF + m * 16; const size_t off = (size_t)r * ldc + col0; float ss = 0.f;
                const float rB = t[(ai * HALF + m * 16) * 2];
#pragma unroll
                for (int bj = 0; bj < 2; ++bj)
#pragma unroll
                    for (int n = 0; n < 2; ++n) { const f32x4 v = *(const PG8_GAS f32x4*)(base + off + bj * HALF + n * 16) + acc[ai][bj][m][n] * rB;
                        *(PG8_GAS f32x4*)(out + off + bj * HALF + n * 16) = v; ss += (v[0] * v[0] + v[1] * v[1]) + (v[2] * v[2] + v[3] * v[3]);
                        u32x2 w; w.x = cvt_pk_bf16(v[0], v[1]); w.y = cvt_pk_bf16(v[2], v[3]); *(PG8_GAS u32x2*)(ob + off + bj * HALF + n * 16) = w; }
                ss += __shfl_xor(ss, 16); ss += __shfl_xor(ss, 32);
                if (fq == 0) slots[(size_t)r * 32 + u.pn * 4 + wc] = ss; }
    }
};

__device__ __forceinline__ float dpp_ror1(float v) { return __builtin_bit_cast(float, __builtin_amdgcn_update_dpp(0, __builtin_bit_cast(int, v), 0x121, 0xf, 0xf, false)); }
__device__ __forceinline__ float dpp_ror2(float v) { return __builtin_bit_cast(float, __builtin_amdgcn_update_dpp(0, __builtin_bit_cast(int, v), 0x122, 0xf, 0xf, false)); }
__device__ __forceinline__ float silu_mul(float gc, float v) { return gc * v * __builtin_amdgcn_rcpf(1.0f + __builtin_amdgcn_exp2f(gc * -1.4426950408889634f)); }
struct EpiConvGlu {
    static constexpr bool PERM = true, AFTER_DRAIN = false, MIDSCALE = false;
    bf16_t* act; int ldc; const float* slots; const float* wconv; const float* bconv; float* GF; float* VF; float* GL;
    __device__ __forceinline__ void operator()(const f32x4 (&acc)[2][2][4][2], const Unit& u, int wr, int wc, int fr, int fq) const {
        const int row0 = u.pm * BM + wr * 64 + fr, col0 = u.pn * HALF + wc * 32 + 8 * fq;
        f32x4 w0[2], w1[2], w2[2], bb[2];
#pragma unroll
        for (int n = 0; n < 2; ++n) { w0[n] = *(const PG8_GAS f32x4*)(wconv + col0 + 4 * n); w1[n] = *(const PG8_GAS f32x4*)(wconv + ldc + col0 + 4 * n); w2[n] = *(const PG8_GAS f32x4*)(wconv + 2 * ldc + col0 + 4 * n); bb[n] = *(const PG8_GAS f32x4*)(bconv + col0 + 4 * n); }
        const bool f0 = fr == 0, f01 = fr < 2;
#pragma unroll
        for (int ai = 0; ai < 2; ++ai) {
            f32x4 g[4][2], v[4][2];
#pragma unroll
            for (int m = 0; m < 4; ++m) { const int r = row0 + ai * HALF + m * 16;
                const PG8_GAS f32x4* sp = (const PG8_GAS f32x4*)(slots + (size_t)r * 32 + fq * 8); const f32x4 a = sp[0], b = sp[1];
                float s = ((a[0] + a[1]) + (a[2] + a[3])) + ((b[0] + b[1]) + (b[2] + b[3])); s += __shfl_xor(s, 16); s += __shfl_xor(s, 32);
                const float sc = 1.0f / sqrtf(s * (1.0f / 2048.0f) + 1e-6f);
#pragma unroll
                for (int n = 0; n < 2; ++n) { g[m][n] = acc[ai][0][m][n] * sc; v[m][n] = acc[ai][1][m][n] * sc; } }
            const int G = (u.pm * BM + ai * HALF + wr * 64) >> 6;
            if (f01) { float* gp = GF + ((size_t)G * 2 + fr) * ldc + col0; float* vp = VF + ((size_t)G * 2 + fr) * ldc + col0;
                *(PG8_GAS f32x4*)gp = g[0][0]; *(PG8_GAS f32x4*)(gp + 4) = g[0][1]; *(PG8_GAS f32x4*)vp = v[0][0]; *(PG8_GAS f32x4*)(vp + 4) = v[0][1]; }
            if (fr >= 14) { float* gp = GL + ((size_t)G * 2 + (fr - 14)) * ldc + col0; *(PG8_GAS f32x4*)gp = g[3][0]; *(PG8_GAS f32x4*)(gp + 4) = g[3][1]; }
            unsigned wpk[4][4];
#pragma unroll
            for (int n = 0; n < 2; ++n)
#pragma unroll
                for (int jp = 0; jp < 2; ++jp) { float o[4][2];
#pragma unroll
                    for (int jj = 0; jj < 2; ++jj) { const int j = 2 * jp + jj; float T[4], U[4];
#pragma unroll
                        for (int m = 0; m < 4; ++m) { T[m] = dpp_ror1(g[m][n][j]); U[m] = dpp_ror2(g[m][n][j]); }
#pragma unroll
                        for (int m = 0; m < 4; ++m) { const float g1 = (m > 0 && f0) ? T[m > 0 ? m - 1 : 0] : T[m], g2 = (m > 0 && f01) ? U[m > 0 ? m - 1 : 0] : U[m];
                            const float gc = bb[n][j] + w0[n][j] * g2 + w1[n][j] * g1 + w2[n][j] * g[m][n][j];
                            o[m][jj] = silu_mul(gc, v[m][n][j]); } }
#pragma unroll
                    for (int m = 0; m < 4; ++m) wpk[m][2 * n + jp] = cvt_pk_bf16(o[m][0], o[m][1]);
                    asm volatile("" ::: "memory"); }
#pragma unroll
            for (int m = 0; m < 4; ++m) { u32x4 w; w.x = wpk[m][0]; w.y = wpk[m][1]; w.z = wpk[m][2]; w.w = wpk[m][3];
                if (m > 0 || !f01) *(u32x4*)(act + (size_t)(row0 + ai * HALF + m * 16) * ldc + col0) = w; }
        }
    }
};

template <class Epi, class Sched, bool ALIGN_EPI = false, bool SP2 = false>
__device__ __forceinline__ void gemm_phase(PG8_LAS unsigned char* lds, const Gemm g, const Sched& S, const Epi& E) {
    int tid = threadIdx.x; asm volatile("" : "+v"(tid));
    const int wid = __builtin_amdgcn_readfirstlane(tid >> 6), lane = tid & 63, wr = wid >> 2, wc = wid & 3, fr = lane & 15, fq = lane >> 4;
    const int K = g.K, nt = K / BK;
    unsigned voffA[2], voffB[2];
#pragma unroll
    for (int i = 0; i < 2; ++i) { int R, C; stage_rc(tid * 16 + i * 8192, R, C); const int Rb = Epi::PERM ? ((R & ~31) + perm32(R & 31)) : R;
        voffA[i] = (unsigned)(R * K + C) * 2u; voffB[i] = (unsigned)(Rb * K + C) * 2u; }
    const size_t kstep = (size_t)(BK * 2);
    const size_t hstep = (size_t)HALF * K * 2;
    const size_t tstep = 2 * hstep;
    const unsigned ldsw = (unsigned)wid * 1024u;
    const int aoff = lds_byte(wr * 64 + fr, fq * 8), boff = lds_byte(wc * 32 + fr, fq * 8);
#define PG8_SA(b, h) (((b) * 2 + (h)) * HTB)
#define PG8_SB(b, h) ((4 + (b) * 2 + (h)) * HTB)
#define PG8_STAGE(bufoff, gbase, voff) do { _Pragma("unroll") for (int _i = 0; _i < 2; ++_i) \
        __builtin_amdgcn_global_load_lds((const unsigned*)((const char*)(gbase) + (voff)[_i]), (PG8_LAS unsigned*)(lds + (bufoff) + ldsw + _i * 8192), 16, 0, 0); } while (0)
#define PG8_LDA(dst, b, h) do { _Pragma("unroll") for (int m = 0; m < 4; ++m) _Pragma("unroll") for (int k = 0; k < 2; ++k) dst[m][k] = *(const PG8_LAS bf16x8*)(lds + PG8_SA(b, h) + aoff + m * 2048 + k * 1024); } while (0)
#define PG8_LDB(dst, b, h) do { _Pragma("unroll") for (int n = 0; n < 2; ++n) _Pragma("unroll") for (int k = 0; k < 2; ++k) dst[n][k] = *(const PG8_LAS bf16x8*)(lds + PG8_SB(b, h) + boff + n * 2048 + k * 1024); } while (0)
#define PG8_MMA(ai, bj, At, Bt) do { __builtin_amdgcn_s_setprio(1); _Pragma("unroll") for (int m = 0; m < 4; ++m) _Pragma("unroll") for (int n = 0; n < 2; ++n) _Pragma("unroll") for (int k = 0; k < 2; ++k) \
        acc[ai][bj][m][n] = __builtin_amdgcn_mfma_f32_16x16x32_bf16(Bt[n][k], At[m][k], acc[ai][bj][m][n], 0, 0, 0); __builtin_amdgcn_s_setprio(0); } while (0)
#define PG8_WAIT_V(n) asm volatile("s_waitcnt vmcnt(" #n ")" ::: "memory")
#define PG8_WAIT_L(n) asm volatile("s_waitcnt lgkmcnt(" #n ")" ::: "memory")
#define PG8_BAR __builtin_amdgcn_s_barrier()
#define PG8_SCHED __builtin_amdgcn_sched_barrier(0)
    Unit cur, nxt; int ui = 0;
    if (!S.next(0, cur)) return;
    f32x4 acc[2][2][4][2];
#pragma unroll
    for (int a = 0; a < 2; ++a)
#pragma unroll
        for (int b = 0; b < 2; ++b)
#pragma unroll
            for (int m = 0; m < 4; ++m)
#pragma unroll
                for (int n = 0; n < 2; ++n) acc[a][b][m][n] = (f32x4){0.f, 0.f, 0.f, 0.f};
    bf16x8 At[4][2], B0[2][2], B1[2][2];
    const char* cA = (const char*)g.A + (size_t)cur.pm * tstep; const char* cB = (const char*)g.Bt + (size_t)cur.pn * tstep;
    S.a_ready(cur);
    if constexpr (SP2) {
        PG8_STAGE(PG8_SB(0, 0), cB, voffB); PG8_STAGE(PG8_SB(0, 1), cB + hstep, voffB); PG8_STAGE(PG8_SA(0, 0), cA, voffA); PG8_STAGE(PG8_SA(0, 1), cA + hstep, voffA);
        if (wr == 1) PG8_BAR;
        PG8_WAIT_V(2); PG8_BAR;
        PG8_STAGE(PG8_SB(1, 0), cB + kstep, voffB); PG8_STAGE(PG8_SA(1, 0), cA + kstep, voffA); PG8_STAGE(PG8_SB(1, 1), cB + hstep + kstep, voffB);
        PG8_WAIT_V(6); PG8_BAR;
    } else {
        PG8_STAGE(PG8_SB(0, 0), cB, voffB); PG8_STAGE(PG8_SA(0, 0), cA, voffA); PG8_STAGE(PG8_SB(0, 1), cB + hstep, voffB); PG8_STAGE(PG8_SA(0, 1), cA + hstep, voffA);
        if (wr == 1) PG8_BAR;
        PG8_WAIT_V(4); PG8_BAR;
        PG8_STAGE(PG8_SB(1, 0), cB + kstep, voffB); PG8_STAGE(PG8_SA(1, 0), cA + kstep, voffA); PG8_STAGE(PG8_SB(1, 1), cB + hstep + kstep, voffB);
        PG8_WAIT_V(6); PG8_BAR;
    }
    for (;;) {
        const bool has_next = S.next(ui + 1, nxt);
        const char* nA = has_next ? (const char*)g.A + (size_t)nxt.pm * tstep : cA; const char* nB = has_next ? (const char*)g.Bt + (size_t)nxt.pn * tstep : cB;
        for (int t = 0; t < nt; t += 2) {
            const bool last = (t == nt - 2);
            const char* a1 = cA + (size_t)(t + 1) * kstep;
            const char* a2 = last ? nA : cA + (size_t)(t + 2) * kstep; const char* b2 = last ? nB : cB + (size_t)(t + 2) * kstep;
            const char* a3 = a2 + kstep; const char* b3 = b2 + kstep;
            if (last && has_next) S.a_ready(nxt);
            if constexpr (Epi::MIDSCALE) { if (t == nt / 2) E.midscale(acc, cur, wr, wc, fr, fq); }
            if constexpr (SP2) {
            PG8_LDB(B0, 0, 0); PG8_LDB(B1, 0, 1); PG8_SCHED; PG8_LDA(At, 0, 0); PG8_STAGE(PG8_SA(1, 1), a1 + hstep, voffA);
            PG8_WAIT_V(8); PG8_WAIT_L(0); PG8_BAR; PG8_MMA(0, 0, At, B0); PG8_MMA(0, 1, At, B1); PG8_BAR; PG8_SCHED;
            PG8_LDA(At, 0, 1); PG8_STAGE(PG8_SB(0, 0), b2, voffB); PG8_STAGE(PG8_SB(0, 1), b2 + hstep, voffB); PG8_STAGE(PG8_SA(0, 0), a2, voffA);
            PG8_WAIT_V(8); PG8_WAIT_L(0); PG8_BAR; PG8_MMA(1, 0, At, B0); PG8_MMA(1, 1, At, B1); PG8_BAR; PG8_SCHED;
            PG8_LDB(B0, 1, 0); PG8_LDB(B1, 1, 1); PG8_SCHED; PG8_LDA(At, 1, 0); PG8_STAGE(PG8_SA(0, 1), a2 + hstep, voffA);
            PG8_WAIT_V(8); PG8_WAIT_L(0); PG8_BAR; PG8_MMA(0, 0, At, B0); PG8_MMA(0, 1, At, B1); PG8_BAR; PG8_SCHED;
            PG8_LDA(At, 1, 1); PG8_STAGE(PG8_SB(1, 0), b3, voffB); PG8_STAGE(PG8_SB(1, 1), b3 + hstep, voffB); PG8_STAGE(PG8_SA(1, 0), a3, voffA);
            PG8_WAIT_V(8); PG8_WAIT_L(0); PG8_BAR; PG8_MMA(1, 0, At, B0); PG8_MMA(1, 1, At, B1); PG8_BAR; PG8_SCHED;
            } else {
            PG8_LDB(B0, 0, 0); PG8_SCHED; PG8_LDA(At, 0, 0); PG8_STAGE(PG8_SA(1, 1), a1 + hstep, voffA);
            PG8_WAIT_L(8); PG8_BAR; PG8_WAIT_L(0); PG8_MMA(0, 0, At, B0); PG8_BAR; PG8_SCHED;
            PG8_LDB(B1, 0, 1); PG8_STAGE(PG8_SB(0, 0), b2, voffB);
            PG8_BAR; PG8_WAIT_L(0); PG8_MMA(0, 1, At, B1); PG8_BAR;
            PG8_LDA(At, 0, 1); PG8_STAGE(PG8_SA(0, 0), a2, voffA);
            PG8_BAR; PG8_WAIT_L(0); PG8_MMA(1, 0, At, B0); PG8_BAR; PG8_SCHED;
            PG8_STAGE(PG8_SB(0, 1), b2 + hstep, voffB);
            PG8_WAIT_V(6); PG8_BAR; PG8_MMA(1, 1, At, B1); PG8_BAR;
            PG8_LDB(B0, 1, 0); PG8_SCHED; PG8_LDA(At, 1, 0); PG8_STAGE(PG8_SA(0, 1), a2 + hstep, voffA);
            PG8_WAIT_L(8); PG8_BAR; PG8_WAIT_L(0); PG8_MMA(0, 0, At, B0); PG8_BAR; PG8_SCHED;
            PG8_LDB(B1, 1, 1); PG8_STAGE(PG8_SB(1, 0), b3, voffB);
            PG8_BAR; PG8_WAIT_L(0); PG8_MMA(0, 1, At, B1); PG8_BAR;
            PG8_LDA(At, 1, 1); PG8_STAGE(PG8_SA(1, 0), a3, voffA);
            PG8_BAR; PG8_WAIT_L(0); PG8_MMA(1, 0, At, B0); PG8_BAR; PG8_SCHED;
            PG8_STAGE(PG8_SB(1, 1), b3 + hstep, voffB);
            PG8_WAIT_V(6); PG8_BAR; PG8_MMA(1, 1, At, B1); PG8_BAR;
            }
        }
        if constexpr (ALIGN_EPI) { if (wr == 0) PG8_BAR; }
        if constexpr (!Epi::AFTER_DRAIN) { E(acc, cur, wr, wc, fr, fq); S.done(cur); }
        if (!has_next) break;
#pragma unroll
        for (int a = 0; a < 2; ++a)
#pragma unroll
            for (int b = 0; b < 2; ++b)
#pragma unroll
                for (int m = 0; m < 4; ++m)
#pragma unroll
                    for (int n = 0; n < 2; ++n) acc[a][b][m][n] = (f32x4){0.f, 0.f, 0.f, 0.f};
        cur = nxt; cA = nA; cB = nB; ++ui;
        if constexpr (ALIGN_EPI) { if (wr == 1) PG8_BAR; }
    }
    PG8_WAIT_V(0);
    if constexpr (!ALIGN_EPI) { if (wr == 0) PG8_BAR; }
    PG8_BAR;
#undef PG8_SA
#undef PG8_SB
#undef PG8_STAGE
#undef PG8_LDA
#undef PG8_LDB
#undef PG8_MMA
#undef PG8_WAIT_V
#undef PG8_WAIT_L
#undef PG8_BAR
#undef PG8_SCHED
}
}

constexpr int NWAVES = 8;
constexpr int M = 16384, DM = 2048, DIN = 4352, DFF = 5632, HD = 64;
constexpr int QA_OFF = 0, KA_OFF = 1024, VA_OFF = 1152, QS_OFF = 1280, KS_OFF = 2304, VS_OFF = 3328;
constexpr float EPS = 1e-6f;

constexpr size_t MiB = 1u << 20;
constexpr size_t WS_CTL = 0, CTL_ZERO_BYTES = 64 * 1024;
constexpr size_t WS_RSTD1 = 1 * MiB;
constexpr size_t WS_SS2 = 2 * MiB, WS_SS3 = 4 * MiB, WS_SSY = 6 * MiB;
constexpr size_t WS_WUP = 8 * MiB;
constexpr size_t WS_WDOWN = 52 * MiB;
constexpr size_t WS_XB = 74 * MiB;
constexpr size_t WS_ACT = 138 * MiB;
constexpr size_t WS_GF = 364 * MiB, WS_VF = 376 * MiB, WS_GL = 388 * MiB;
constexpr size_t WS_WIN = 138 * MiB;
constexpr size_t WS_WOUT = 155 * MiB;
constexpr size_t WS_PROJ = 163 * MiB;
constexpr size_t WS_MIX = 299 * MiB;
constexpr size_t WS_END = 400 * MiB;
constexpr int CW_BAR = 4096;

constexpr int RING_BYTES = 131072, ATT_TAB_OFF = RING_BYTES  , ATT_WSF_OFF = ATT_TAB_OFF + 16384  , LDSCTL_OFF = ATT_WSF_OFF + 2048, MISC_OFF = LDSCTL_OFF + 320, LDS_BYTES = 155648;

#define GAS __attribute__((address_space(1)))
#define LAS __attribute__((address_space(3)))
typedef unsigned short bf16;
typedef unsigned v4u __attribute__((ext_vector_type(4)));
typedef float f32x4 __attribute__((ext_vector_type(4)));
#define LDS_WAIT() asm volatile("s_waitcnt lgkmcnt(0)" ::: "memory")
__device__ __forceinline__ unsigned f2bf(float f) { unsigned u = __builtin_bit_cast(unsigned, f); return (u + 0x7fffu + ((u >> 16) & 1u)) >> 16; }
__device__ __forceinline__ unsigned pk2(float lo, float hi) { return f2bf(lo) | (f2bf(hi) << 16); }
__device__ __forceinline__ float bf2f(unsigned h) { return __builtin_bit_cast(float, h << 16); }
__device__ __forceinline__ float wave_sum(float v) {
#pragma unroll
    for (int o = 1; o < 64; o <<= 1) v += __shfl_xor(v, o);
    return v;
}

#define XB_TMO      128
#define XB_XCNT(j)  (256  + 64 * (j))
#define XB_XSUB(j)  (1280 + 64 * (j))
#define XB_XGEN(j)  (2304 + 64 * (j))
#define XB_TOP      3328
#define XB_TOPGEN   3392
#define XCD_BAR_WORDS 3456
#define XB_SPIN_CAP (1u << 18)
__device__ __forceinline__ unsigned xb_ld(unsigned* p)              { return __hip_atomic_load(p, __ATOMIC_RELAXED, __HIP_MEMORY_SCOPE_AGENT); }
__device__ __forceinline__ unsigned xb_add(unsigned* p, unsigned v) { return __hip_atomic_fetch_add(p, v, __ATOMIC_RELAXED, __HIP_MEMORY_SCOPE_AGENT); }
__device__ __forceinline__ unsigned xb_xcc_id() { return (unsigned)__builtin_amdgcn_s_getreg((3 << 11) | 20) & 0xFu; }
#define XB_SPIN(cond, bar) do { unsigned _sp = 0; while (cond) { __builtin_amdgcn_s_sleep(1); \
    if ((++_sp & 255u) == 0u) { if (xb_ld(&(bar)[XB_TMO])) break; if (_sp > XB_SPIN_CAP) { atomicAdd(&(bar)[XB_TMO], 1u); break; } } } } while (0)
struct XcdBarrier { unsigned* bar; unsigned x; volatile LAS unsigned* st; };
__device__ __forceinline__ XcdBarrier xcd_barrier_post(unsigned* bar, volatile LAS unsigned* st) {
    XcdBarrier b; b.bar = bar; b.x = xb_xcc_id(); b.st = st;
    if (threadIdx.x == 0) (void)xb_add(&bar[XB_XCNT(b.x)], 1u);
    return b;
}
__device__ __forceinline__ void xcd_barrier_complete(unsigned* bar, unsigned x, unsigned& nloc, unsigned& nx) {
    const unsigned G = gridDim.x * gridDim.y * gridDim.z;
    unsigned sum, cnt, mine, sp = 0u;
    for (;;) {
        sum = 0u; cnt = 0u; mine = 0u;
#pragma unroll
        for (unsigned j = 0; j < 16; ++j) { const unsigned c = xb_ld(&bar[XB_XCNT(j)]); sum += c; cnt += (c > 0u) ? 1u : 0u; mine = (j == x) ? c : mine; }
        if (sum == G) break;
        __builtin_amdgcn_s_sleep(1);
        if ((++sp & 255u) == 0u) { if (xb_ld(&bar[XB_TMO])) break; if (sp > XB_SPIN_CAP) { atomicAdd(&bar[XB_TMO], 1u); break; } }
    }
    nloc = mine > 0u ? mine : 1u; nx = cnt > 0u ? cnt : 1u;
}
__device__ __forceinline__ void xcd_barrier(const XcdBarrier& b) {
    asm volatile("s_waitcnt vmcnt(0)" ::: "memory");
    __syncthreads();
    if (threadIdx.x == 0) {
        unsigned* bar = b.bar;
        __builtin_amdgcn_s_waitcnt(0);
        unsigned nloc = b.st[0], nx = b.st[1];
        if (nloc == 0u) { xcd_barrier_complete(bar, b.x, nloc, nx); b.st[0] = nloc; b.st[1] = nx; }
        const unsigned old = xb_add(&bar[XB_XSUB(b.x)], 1u);
        const unsigned gen = old / nloc;
        if (old + 1u == (gen + 1u) * nloc) {
            __builtin_amdgcn_fence(__ATOMIC_RELEASE, "agent");
            asm volatile("s_waitcnt vmcnt(0)" ::: "memory");
            const unsigned og = xb_add(&bar[XB_TOP], 1u);
            const unsigned tg = og / nx;
            if (og + 1u == (tg + 1u) * nx) xb_add(&bar[XB_TOPGEN], 1u);
            else XB_SPIN(xb_ld(&bar[XB_TOPGEN]) == tg, bar);
            __builtin_amdgcn_fence(__ATOMIC_ACQUIRE, "agent");
            xb_add(&bar[XB_XGEN(b.x)], 1u);
            asm volatile("s_waitcnt vmcnt(0)" ::: "memory");
        } else {
            XB_SPIN(xb_ld(&bar[XB_XGEN(b.x)]) == gen, bar);
            __builtin_amdgcn_fence(__ATOMIC_ACQUIRE, "agent");
            asm volatile("s_waitcnt vmcnt(0)" ::: "memory");
        }
    }
    __syncthreads();
}

__device__ const unsigned char kBucket[128] = {
    0, 1, 2, 3, 4, 5, 6, 7, 8, 9, 10, 11, 12, 13, 14, 15, 16, 16, 16, 17, 17, 18, 18, 18, 19, 19, 19, 20, 20, 20, 20, 21, 21, 21, 21, 22, 22, 22, 22, 22, 23, 23, 23, 23, 23, 23, 24, 24, 24, 24, 24, 24, 25, 25, 25, 25, 25, 25, 25, 26, 26, 26, 26, 26, 26, 26, 26, 27, 27, 27, 27, 27, 27, 27, 27, 27, 27, 28, 28, 28, 28, 28, 28, 28, 28, 28, 28, 29, 29, 29, 29, 29, 29, 29, 29, 29, 29, 29, 29, 30, 30, 30, 30, 30, 30, 30, 30, 30, 30, 30, 30, 30, 30, 31, 31, 31, 31, 31, 31, 31, 31, 31, 31, 31, 31, 31, 31, 31};

__device__ __forceinline__ void p0_transpose_item(const float* W, const float* gk, int K, int N, bf16* WT, LAS float* scr, int item, int lane, bool qscale = false, bool glu_rows = false) {
    const int nblk = N / 32, kb = item / nblk, nb = item % nblk, k0 = 64 * kb, n0 = 32 * nb;
    const float cs = (qscale && (n0 < 1024 || (n0 >= QS_OFF && n0 < KS_OFF))) ? 0.125f * 1.4426950408889634f : 1.0f;
#pragma unroll 8
    for (int i = 0; i < 32; ++i) { const int kk = 2 * i + (lane >> 5); float v = W[(size_t)(k0 + kk) * N + n0 + (lane & 31)]; if (gk) v *= gk[k0 + kk]; scr[kk * 33 + (lane & 31)] = v * cs; }
    LDS_WAIT(); asm volatile("" ::: "memory");
    const int c = lane & 7;
#pragma unroll
    for (int j = 0; j < 4; ++j) { const int n = (lane >> 3) + 8 * j; const LAS float* s = scr + (8 * c) * 33 + n;
        v4u o; o.x = pk2(s[0 * 33], s[1 * 33]); o.y = pk2(s[2 * 33], s[3 * 33]); o.z = pk2(s[4 * 33], s[5 * 33]); o.w = pk2(s[6 * 33], s[7 * 33]);
        int nrow = n0 + n; if (glu_rows) { const int hv = nrow >= DFF, n2 = hv ? nrow - DFF : nrow; nrow = 256 * (n2 >> 7) + 128 * hv + (n2 & 127); }
        *(GAS v4u*)(WT + (size_t)nrow * K + k0 + 8 * c) = o; }
    LDS_WAIT(); asm volatile("" ::: "memory");
}
__device__ __forceinline__ void row_cvt(const float* xrow, bf16* orow, float* rstd, int lane) {
    const f32x4* xr = (const f32x4*)xrow + lane;
    f32x4 v[8]; float s = 0.f;
#pragma unroll
    for (int j = 0; j < 8; ++j) { v[j] = xr[64 * j]; s += (v[j].x * v[j].x + v[j].y * v[j].y) + (v[j].z * v[j].z + v[j].w * v[j].w); }
    s = wave_sum(s);
    if (lane == 0) *rstd = 1.0f / sqrtf(s * (1.0f / DM) + EPS);
    unsigned long long* o8 = (unsigned long long*)orow + lane;
#pragma unroll
    for (int j = 0; j < 8; ++j) o8[64 * j] = (unsigned long long)pk2(v[j].x, v[j].y) | ((unsigned long long)pk2(v[j].z, v[j].w) << 32);
}

namespace att {
typedef short bf16x8 __attribute__((ext_vector_type(8)));
typedef short s16x4 __attribute__((ext_vector_type(4)));
typedef short v4i16_t __attribute__((ext_vector_type(4)));
typedef float f32x16 __attribute__((ext_vector_type(16)));
typedef unsigned u32x4 __attribute__((ext_vector_type(4)));
typedef float f32x2_t __attribute__((ext_vector_type(2))); typedef __bf16 bf16x2_t __attribute__((ext_vector_type(2)));
typedef LAS const char* lds_cptr;
constexpr float LOG2E = 1.4426950408889634f;
constexpr float QSCALE = 0.125f * LOG2E;
constexpr float SB_EXIT = 150.2f;
__device__ __forceinline__ int crow(int r, int hi) { return (r & 3) + 8 * (r >> 2) + 4 * hi; }
__device__ __forceinline__ unsigned cvtpk(float lo, float hi) { f32x2_t v = {lo, hi}; bf16x2_t b = __builtin_convertvector(v, bf16x2_t); return __builtin_bit_cast(unsigned, b); }
__device__ __forceinline__ s16x4 vtr(lds_cptr p) { return __builtin_bit_cast(s16x4, __builtin_amdgcn_ds_read_tr16_b64_v4i16((LAS v4i16_t*)p)); }
#define ATT_WAITV(n) asm volatile("s_waitcnt vmcnt(" #n ")" ::: "memory")
#define ATT_WAITL() asm volatile("s_waitcnt lgkmcnt(0)" ::: "memory")

__device__ __forceinline__ unsigned k_voff(int lane, int odd) { const int sw = (lane >> 4) + 4 * odd, c = (lane & 7) ^ sw; return (unsigned)((lane >> 3) * DIN * 2 + c * 16); }
__device__ __forceinline__ void dma_k(const bf16* src, LAS unsigned char* kreg, unsigned vk0, unsigned vk1) {
#pragma unroll
    for (int i = 0; i < 8; ++i) { const char* ub = (const char*)src + (size_t)i * (8 * DIN * 2);
        __builtin_amdgcn_global_load_lds((const unsigned*)(ub + ((i & 1) ? vk1 : vk0)), (LAS unsigned*)(kreg + i * 1024), 16, 0, 0); }
}
__device__ __forceinline__ unsigned v_voff(int lane) { return (unsigned)((lane >> 2) * DIN * 2 + (lane & 3) * 16); }
__device__ __forceinline__ void dma_v(const bf16* src, LAS unsigned char* vreg, unsigned vv) {
#pragma unroll
    for (int p = 0; p < 8; ++p) { const char* ub = (const char*)src + (size_t)(p & 3) * (16 * DIN * 2) + (p >> 2) * 64;
        __builtin_amdgcn_global_load_lds((const unsigned*)(ub + vv), (LAS unsigned*)(vreg + p * 1024), 16, 0, 0); }
}
__device__ __forceinline__ void load_kf(bf16x8 (&kf)[8], lds_cptr kreg, int r32, int hi) {
    const lds_cptr kp = kreg + r32 * 128; const int sw = (r32 >> 1) & 7;
#pragma unroll
    for (int d0 = 0; d0 < 4; ++d0) { const int off = ((2 * d0 + hi) ^ sw) * 16;
        kf[2 * d0] = *(const LAS bf16x8*)(kp + off); kf[2 * d0 + 1] = *(const LAS bf16x8*)(kp + 4096 + off); }
}
__device__ __forceinline__ void qkt(f32x16& p0, f32x16& p1, const bf16x8 (&kf)[8], const bf16x8 (&qr)[4]) {
    const f32x16 z = {};
    p0 = __builtin_amdgcn_mfma_f32_32x32x16_bf16(kf[0], qr[0], z, 0, 0, 0); p1 = __builtin_amdgcn_mfma_f32_32x32x16_bf16(kf[1], qr[0], z, 0, 0, 0);
#pragma unroll
    for (int d0 = 1; d0 < 4; ++d0) { p0 = __builtin_amdgcn_mfma_f32_32x32x16_bf16(kf[2 * d0], qr[d0], p0, 0, 0, 0); p1 = __builtin_amdgcn_mfma_f32_32x32x16_bf16(kf[2 * d0 + 1], qr[d0], p1, 0, 0, 0); }
}
__device__ __forceinline__ void pv(f32x16 (&o)[2], lds_cptr vp0, const f32x16& p0, const f32x16& p1) {
    u32x4 pw[4];
#pragma unroll
    for (int j = 0; j < 4; ++j) { pw[0][j] = cvtpk(p0[2 * j], p0[2 * j + 1]); pw[1][j] = cvtpk(p0[8 + 2 * j], p0[9 + 2 * j]); pw[2][j] = cvtpk(p1[2 * j], p1[2 * j + 1]); pw[3][j] = cvtpk(p1[8 + 2 * j], p1[9 + 2 * j]); }
#pragma unroll
    for (int d0 = 0; d0 < 2; ++d0)
#pragma unroll
        for (int ks = 0; ks < 4; ++ks) { const s16x4 lo = vtr(vp0 + d0 * 4096 + ks * 1024), hi4 = vtr(vp0 + d0 * 4096 + ks * 1024 + 512);
            const bf16x8 vf = (bf16x8){lo[0], lo[1], lo[2], lo[3], hi4[0], hi4[1], hi4[2], hi4[3]};
            o[d0] = __builtin_amdgcn_mfma_f32_32x32x16_bf16(__builtin_bit_cast(bf16x8, pw[ks]), vf, o[d0], 0, 0, 0); }
}
__device__ __forceinline__ float swap_other(float v) { auto rr = __builtin_amdgcn_permlane32_swap(__float_as_uint(v), __float_as_uint(v), false, false); return (threadIdx.x & 32) ? __uint_as_float(rr[0]) : __uint_as_float(rr[1]); }

template <bool SCALE> __device__ __forceinline__ void store_o(const f32x16 (&o)[2], LAS unsigned char* kreg, LAS float* wsf, bf16* y, float* slots, int tok0, int col0, int slot, int lane) {
    const int r32 = lane & 31, hi = lane >> 5;
    LAS float* stg = (LAS float*)kreg;
#pragma unroll
    for (int r = 0; r < 16; ++r) { const int row = crow(r, hi); stg[row * 64 + r32] = o[0][r]; stg[row * 64 + 32 + r32] = o[1][r]; }
    ATT_WAITL();
#pragma unroll
    for (int i = 0; i < 4; ++i) { const int row = i * 8 + (lane >> 3), ch = lane & 7;
        const f32x4 a = *(const LAS f32x4*)(stg + row * 64 + ch * 8), b = *(const LAS f32x4*)(stg + row * 64 + ch * 8 + 4);
        const float s = SCALE ? wsf[32 + row] : 1.0f;
        const f32x4 a2 = a * s, b2 = b * s;
        float ss = ((a2[0] * a2[0] + a2[1] * a2[1]) + (a2[2] * a2[2] + a2[3] * a2[3])) + ((b2[0] * b2[0] + b2[1] * b2[1]) + (b2[2] * b2[2] + b2[3] * b2[3]));
        ss += __shfl_xor(ss, 1); ss += __shfl_xor(ss, 2); ss += __shfl_xor(ss, 4);
        v4u w; w.x = cvtpk(a2[0], a2[1]); w.y = cvtpk(a2[2], a2[3]); w.z = cvtpk(b2[0], b2[1]); w.w = cvtpk(b2[2], b2[3]);
        *(GAS v4u*)(y + (size_t)(tok0 + row) * DM + col0 + ch * 8) = w;
        if (ch == 0) *(GAS float*)(slots + (size_t)(tok0 + row) * 32 + slot) = ss; }
    ATT_WAITL();
}

__device__ __forceinline__ void swa_item(const bf16* proj, LAS unsigned char* kreg, LAS unsigned char* vreg, LAS float* wsf, const LAS float* tab, float sink2, bf16* y, float* slots, int h, int q0, int lane) {
    const int r32 = lane & 31, hi = lane >> 5, kvh = h >> 3;
    const bf16* Kb = proj + KA_OFF + kvh * HD; const bf16* Vb = proj + VA_OFF + kvh * HD;
    const int kt_hi = q0 >> 6; int kt = kt_hi - 2 < 0 ? 0 : kt_hi - 2;
    const unsigned vk0 = k_voff(lane, 0), vk1 = k_voff(lane, 1), vv = v_voff(lane);
    dma_k(Kb + (size_t)kt * 64 * DIN, kreg, vk0, vk1); dma_v(Vb + (size_t)kt * 64 * DIN, vreg, vv);
    bf16x8 qr[4];
#pragma unroll
    for (int d0 = 0; d0 < 4; ++d0) qr[d0] = *(const GAS bf16x8*)(proj + (size_t)(q0 + r32) * DIN + QA_OFF + h * HD + d0 * 16 + hi * 8);
    const lds_cptr vp0 = (lds_cptr)vreg + ((lane >> 4) & 1) * 32 + (lane & 3) * 8 + (4 * hi + ((lane & 15) >> 2)) * 64;
    f32x16 o[2]; o[0] = f32x16{}; o[1] = f32x16{};
    float m = sink2, l = hi ? 0.f : 1.0f;
    const LAS float* tb = tab + h * 256;
    for (;; ++kt) {
        const bool more = kt < kt_hi;
        ATT_WAITV(8);
        bf16x8 kf[8]; load_kf(kf, (lds_cptr)kreg, r32, hi); ATT_WAITL();
        if (more) dma_k(Kb + (size_t)(kt + 1) * 64 * DIN, kreg, vk0, vk1);
        f32x16 p0, p1; qkt(p0, p1, kf, qr);
        const LAS float* t0 = tb + (191 - (q0 + r32 - 64 * kt - 4 * hi));
#pragma unroll
        for (int r = 0; r < 16; ++r) { const int cr = (r & 3) + 8 * (r >> 2); p0[r] += t0[cr]; p1[r] += t0[32 + cr]; }
        float rm = fmaxf(p0[0], p1[0]);
#pragma unroll
        for (int r = 1; r < 16; ++r) rm = fmaxf(rm, fmaxf(p0[r], p1[r]));
        rm = fmaxf(rm, swap_other(rm));
        const float mn = fmaxf(m, rm), f = __builtin_amdgcn_exp2f(m - mn); m = mn;
        float ps = 0.f;
#pragma unroll
        for (int r = 0; r < 16; ++r) { p0[r] = __builtin_amdgcn_exp2f(p0[r] - mn); p1[r] = __builtin_amdgcn_exp2f(p1[r] - mn); ps += p0[r] + p1[r]; }
        l = l * f + ps;
        if (__any(f != 1.0f)) {
            if (hi == 0) wsf[r32] = f;
            ATT_WAITL();
#pragma unroll
            for (int r = 0; r < 16; ++r) { const float fr_ = wsf[crow(r, hi)]; o[0][r] *= fr_; o[1][r] *= fr_; }
            ATT_WAITL();
        }
        if (more) ATT_WAITV(8); else ATT_WAITV(0);
        pv(o, vp0, p0, p1); ATT_WAITL();
        if (!more) break;
        dma_v(Vb + (size_t)(kt + 1) * 64 * DIN, vreg, vv);
    }
    l += swap_other(l);
    if (hi == 0) wsf[32 + r32] = 1.0f / l;
    ATT_WAITL();
    store_o<true>(o, kreg, wsf, y, slots, q0, h * HD, h, lane);
}

__device__ __forceinline__ void sb_item(const bf16* proj, LAS unsigned char* kreg, LAS unsigned char* vreg, bf16* y, float* slots, int h, int q0, int lane) {
    const int r32 = lane & 31, hi = lane >> 5;
    const bf16* Kb = proj + KS_OFF + h * HD; const bf16* Vb = proj + VS_OFF + h * HD;
    int kt = q0 >> 6;
    const unsigned vk0 = k_voff(lane, 0), vk1 = k_voff(lane, 1), vv = v_voff(lane);
    dma_k(Kb + (size_t)kt * 64 * DIN, kreg, vk0, vk1); dma_v(Vb + (size_t)kt * 64 * DIN, vreg, vv);
    bf16x8 qr[4];
#pragma unroll
    for (int d0 = 0; d0 < 4; ++d0) qr[d0] = *(const GAS bf16x8*)(proj + (size_t)(q0 + r32) * DIN + QS_OFF + h * HD + d0 * 16 + hi * 8);
    const lds_cptr vp0 = (lds_cptr)vreg + ((lane >> 4) & 1) * 32 + (lane & 3) * 8 + (4 * hi + ((lane & 15) >> 2)) * 64;
    f32x16 o[2]; o[0] = f32x16{}; o[1] = f32x16{};
    float R = 0.f;
    bool diag = true;
    for (;; --kt) {
        const bool more = kt > 0;
        ATT_WAITV(8);
        bf16x8 kf[8]; load_kf(kf, (lds_cptr)kreg, r32, hi); ATT_WAITL();
        if (more) dma_k(Kb + (size_t)(kt - 1) * 64 * DIN, kreg, vk0, vk1);
        f32x16 p0, p1; qkt(p0, p1, kf, qr);
        const int qrel = diag ? (q0 + r32 - 64 * kt - 4 * hi) : 1000;
        f32x16 e0, e1; float T[2][4];
#pragma unroll
        for (int r = 0; r < 16; ++r) { const int cr = (r & 3) + 8 * (r >> 2);
            float s0 = fmaxf(p0[r], 0.f) + __builtin_amdgcn_logf(1.0f + __builtin_amdgcn_exp2f(-fabsf(p0[r])));
            float s1 = fmaxf(p1[r], 0.f) + __builtin_amdgcn_logf(1.0f + __builtin_amdgcn_exp2f(-fabsf(p1[r])));
            e0[r] = (cr < qrel) ? s0 : 0.f; e1[r] = (cr + 32 < qrel) ? s1 : 0.f; }
#pragma unroll
        for (int w = 0; w < 4; ++w) { e0[4 * w + 2] += e0[4 * w + 3]; e0[4 * w + 1] += e0[4 * w + 2]; e0[4 * w] += e0[4 * w + 1]; T[0][w] = e0[4 * w];
                                      e1[4 * w + 2] += e1[4 * w + 3]; e1[4 * w + 1] += e1[4 * w + 2]; e1[4 * w] += e1[4 * w + 1]; T[1][w] = e1[4 * w]; }
        float run = R, base[2][4];
#pragma unroll
        for (int u = 1; u >= 0; --u)
#pragma unroll
            for (int w = 3; w >= 0; --w) { const float tp = swap_other(T[u][w]); const float rp = run + tp; base[u][w] = hi ? run : rp; run = rp + T[u][w]; }
#pragma unroll
        for (int r = 0; r < 16; ++r) { const int cr = (r & 3) + 8 * (r >> 2);
            const float a0 = __builtin_amdgcn_exp2f((p0[r] - base[0][r >> 2]) - e0[r]), a1 = __builtin_amdgcn_exp2f((p1[r] - base[1][r >> 2]) - e1[r]);
            p0[r] = (cr < qrel) ? a0 : 0.f; p1[r] = (cr + 32 < qrel) ? a1 : 0.f; }
        R = run;
        if (more) ATT_WAITV(8); else ATT_WAITV(0);
        pv(o, vp0, p0, p1); ATT_WAITL();
        if (!more || __all(R >= SB_EXIT)) break;
        dma_v(Vb + (size_t)(kt - 1) * 64 * DIN, vreg, vv);
        diag = false;
    }
    ATT_WAITV(0);
    store_o<false>(o, kreg, nullptr, y, slots, q0, 1024 + h * HD, 16 + h, lane);
}
#undef ATT_WAITV
#undef ATT_WAITL
}

struct Args { const float* in[14]; float* out; unsigned char* ws; };
__global__ void __launch_bounds__(NWAVES * 64, 2) mk_fwd(Args args) {
    extern __shared__ __attribute__((aligned(16))) unsigned char lds_raw[];
    LAS unsigned char* lds = (LAS unsigned char*)lds_raw;
    volatile LAS unsigned* MISC = (volatile LAS unsigned*)(lds + MISC_OFF);
    const int tid = threadIdx.x;
    const int G = gridDim.x; const int bx = blockIdx.x; const int vcu = (G % 8 == 0) ? (bx % 8) * (G / 8) + bx / 8 : bx;
    unsigned char* ws = args.ws;
    unsigned* ctl = (unsigned*)(ws + WS_CTL);
    const float* x = args.in[0]; const float* w_in = args.in[1]; const float* g_attn = args.in[2]; const float* rel_bias = args.in[3];
    const float* sinks = args.in[4]; const float* g_swa = args.in[5]; const float* g_sb = args.in[6]; const float* w_out = args.in[7];
    const float* g_mlp = args.in[8]; const float* w_up = args.in[9]; const float* w_conv = args.in[10]; const float* b_conv = args.in[11];
    const float* w_down = args.in[12]; const float* g_final = args.in[13];
    float* out = args.out;
    float* rstd1 = (float*)(ws + WS_RSTD1); float* ss2 = (float*)(ws + WS_SS2); float* ss3 = (float*)(ws + WS_SS3);
    bf16* WinT = (bf16*)(ws + WS_WIN); bf16* WoutT = (bf16*)(ws + WS_WOUT); bf16* WupT = (bf16*)(ws + WS_WUP); bf16* WdownT = (bf16*)(ws + WS_WDOWN);
    bf16* xb = (bf16*)(ws + WS_XB); bf16* proj = (bf16*)(ws + WS_PROJ); bf16* mix = (bf16*)(ws + WS_MIX);
    float* ssY = (float*)(ws + WS_SSY);
    bf16* act = (bf16*)(ws + WS_ACT); float* GFb = (float*)(ws + WS_GF); float* VFb = (float*)(ws + WS_VF); float* GLb = (float*)(ws + WS_GL);

    for (int u = tid; u < (LDS_BYTES - LDSCTL_OFF) / 4; u += NWAVES * 64) ((LAS unsigned*)(lds + LDSCTL_OFF))[u] = 0u;
    __syncthreads();
    XcdBarrier bar = xcd_barrier_post(ctl + CW_BAR, MISC + 8);
    const int NGW = G * NWAVES, NGT = G * NWAVES * 64;
#define PHASE_IDS() int tidp = threadIdx.x; asm volatile("" : "+v"(tidp)); const int lane = tidp & 63, wave = __builtin_amdgcn_readfirstlane(tidp >> 6); const int gw = vcu * NWAVES + wave, gt = vcu * (NWAVES * 64) + tidp; (void)lane; (void)gw; (void)gt

#if defined(PROBE_A)
    unsigned long long ts_[12]; int nts_ = 0;
#define STAMP() do { ts_[nts_++] = __builtin_amdgcn_s_memrealtime(); } while (0)
#else
#define STAMP() do { } while (0)
#endif
    STAMP();
#ifndef REP_P0
#define REP_P0 1
#endif
    for (int rep0 = 0; rep0 < REP_P0; ++rep0) {
    {
        PHASE_IDS();
        LAS float* scr = (LAS float*)(lds + wave * 16384);
        constexpr int I_IN = (DM / 64) * (DIN / 32), I_OUT = (DM / 64) * (DM / 32), I_UP = (DM / 64) * (2 * DFF / 32), I_DOWN = (DFF / 64) * (DM / 32);
        constexpr int NITEMS = I_IN + I_OUT + I_UP + I_DOWN;
        for (int it = gw; it < NITEMS; it += NGW) {
            int r = it;
            if (r < I_IN) { p0_transpose_item(w_in, g_attn, DM, DIN, WinT, scr, r, lane, true); continue; } r -= I_IN;
            if (r < I_OUT) { const int k0 = 64 * (r / (DM / 32)); p0_transpose_item(w_out, k0 < 1024 ? g_swa : g_sb - 1024, DM, DM, WoutT, scr, r, lane); continue; } r -= I_OUT;
            if (r < I_UP) { p0_transpose_item(w_up, g_mlp, DM, 2 * DFF, WupT, scr, r, lane, false, true); continue; } r -= I_UP;
            p0_transpose_item(w_down, nullptr, DFF, DM, WdownT, scr, r, lane);
        }
        for (int m = gw; m < M; m += NGW) row_cvt(x + (size_t)m * DM, xb + (size_t)m * DM, rstd1 + m, lane);
    }
    xcd_barrier(bar); STAMP();
    }

#ifndef REP_P1
#define REP_P0 1
#define REP_P1 1
#define REP_P2 1
#define REP_P4 1
#endif
    for (int rep = 0; rep < REP_P1; ++rep) {
    {
        pg8::Gemm g{xb, WinT, M, DIN, DM}; pg8::StaticOrder S; S.init(M, DIN, G, bx);
        pg8::EpiRowScaleBf16 E{proj, proj, DIN, 1 << 30, rstd1, nullptr};
        pg8::gemm_phase<pg8::EpiRowScaleBf16, pg8::StaticOrder, true, true>(lds, g, S, E);
    }
    xcd_barrier(bar); STAMP();
    }

    for (int rep = 0; rep < REP_P2; ++rep) {
    {
        PHASE_IDS();
        LAS float* tab = (LAS float*)(lds + ATT_TAB_OFF);
        for (int i = tidp; i < 16 * 256; i += NWAVES * 64) { const int h = i >> 8, dist = 191 - (i & 255);
            tab[i] = (dist >= 0 && dist < 128) ? rel_bias[kBucket[dist] * 16 + h] * att::LOG2E : -1e30f; }
        __syncthreads();
        LAS unsigned char* kreg = lds + wave * 16384; LAS unsigned char* vreg = kreg + 8192; LAS float* wsf = (LAS float*)(lds + ATT_WSF_OFF) + wave * 64;
        for (int tb = vcu; tb < M / 64; tb += G) {
            const int q0 = 64 * tb + 32 * (wave & 1);
            for (int hh = 0; hh < 4; ++hh) { const int h = 4 * (wave >> 1) + hh; att::swa_item(proj, kreg, vreg, wsf, tab, sinks[h] * att::LOG2E, mix, ssY, h, q0, lane); }
            for (int hh = 0; hh < 4; ++hh) { const int h = 4 * (wave >> 1) + hh; att::sb_item(proj, kreg, vreg, mix, ssY, h, q0, lane); }
        }
    }
    xcd_barrier(bar); STAMP();
    }

    {
        pg8::Gemm g{mix, WoutT, M, DM, DM}; pg8::MixOrder S; S.init(M, DM, G, bx); S.ssY = ssY; S.tab = (LAS float*)(lds + ATT_TAB_OFF);
        pg8::EpiResidualMix E{x, out, xb, DM, ss2, (const LAS float*)(lds + ATT_TAB_OFF)};
        pg8::gemm_phase<pg8::EpiResidualMix, pg8::MixOrder, true, true>(lds, g, S, E);
    }
    xcd_barrier(bar); STAMP();

    for (int rep = 0; rep < REP_P4; ++rep) {
    {
        pg8::Gemm g{xb, WupT, M, 2 * DFF, DM}; pg8::StaticOrder S; S.init(M, 2 * DFF, G, bx);
        pg8::EpiConvGlu E{act, DFF, ss2, w_conv, b_conv, GFb, VFb, GLb};
        pg8::gemm_phase<pg8::EpiConvGlu, pg8::StaticOrder, true, true>(lds, g, S, E);
    }
    xcd_barrier(bar); STAMP();
    }

    { PHASE_IDS();
    for (int i = gt; i < (M / 64) * 2 * (DFF / 4); i += NGT) {
        const int c = (i % (DFF / 4)) * 4, gi = i / (DFF / 4), Gg = gi >> 1, ri = gi & 1;
        const f32x4 z = (f32x4){0.f, 0.f, 0.f, 0.f};
        const f32x4 gv = *(const f32x4*)(GFb + ((size_t)Gg * 2 + ri) * DFF + c), vv = *(const f32x4*)(VFb + ((size_t)Gg * 2 + ri) * DFF + c);
        const f32x4 l1 = Gg > 0 ? *(const f32x4*)(GLb + ((size_t)(Gg - 1) * 2 + 1) * DFF + c) : z, l0 = Gg > 0 ? *(const f32x4*)(GLb + ((size_t)(Gg - 1) * 2 + 0) * DFF + c) : z;
        const f32x4 g1 = ri ? *(const f32x4*)(GFb + ((size_t)Gg * 2) * DFF + c) : l1, g2 = ri ? l1 : l0;
        const f32x4 w0 = *(const f32x4*)(w_conv + c), w1 = *(const f32x4*)(w_conv + DFF + c), w2 = *(const f32x4*)(w_conv + 2 * DFF + c), bb = *(const f32x4*)(b_conv + c);
        float o[4];
#pragma unroll
        for (int j = 0; j < 4; ++j) o[j] = pg8::silu_mul(bb[j] + w0[j] * g2[j] + w1[j] * g1[j] + w2[j] * gv[j], vv[j]);
        *(unsigned long long*)(act + (size_t)(Gg * 64 + ri) * DFF + c) = (unsigned long long)pk2(o[0], o[1]) | ((unsigned long long)pk2(o[2], o[3]) << 32);
    } }
    xcd_barrier(bar); STAMP();

    {
        pg8::Gemm g{act, WdownT, M, DM, DFF}; pg8::StaticOrder S; S.init(M, DM, G, bx);
        pg8::EpiResidual E{out, out, nullptr, DM, ss3};
        pg8::gemm_phase<pg8::EpiResidual, pg8::StaticOrder, true, true>(lds, g, S, E);
    }
    xcd_barrier(bar); STAMP();

    {
        PHASE_IDS();
        const unsigned tmo = xb_ld(ctl + CW_BAR + XB_TMO);
        for (int m = gw; m < M; m += NGW) {
            float s = (lane < 32) ? ss3[(size_t)m * 32 + lane] : 0.f; s = wave_sum(s);
            float r = 1.0f / sqrtf(s * (1.0f / DM) + EPS);
            if (tmo) r = __builtin_nanf("");
            f32x4* xr = (f32x4*)(out + (size_t)m * DM) + lane; const f32x4* gr = (const f32x4*)g_final + lane;
#pragma unroll
            for (int j = 0; j < 8; ++j) { const f32x4 v = xr[64 * j]; xr[64 * j] = v * r * gr[64 * j]; }
        }
    }
#if defined(PROBE_A)
    xcd_barrier(bar); STAMP();
    if (blockIdx.x == 0) {
        const float d1 = (float)(ts_[PROBE_A2] - ts_[PROBE_A]) * 0.01f, d2 = (float)(ts_[PROBE_B2] - ts_[PROBE_B]) * 0.01f;
        if (threadIdx.x == 0) out[0] += d1;
        for (int i = threadIdx.x; i < (1 << 20); i += NWAVES * 64) out[4096 + i] += d2;
    }
#endif
}

extern "C" void kernel_launch(void* const* d_in, const int* in_sizes, int n_in, void* d_out, int out_size, void* d_ws, size_t ws_size, hipStream_t stream) {
    static int grid = 0;
    if (grid == 0) {
        if (n_in != 14 || out_size != M * DM || ws_size < WS_END) { fprintf(stderr, "kernel_launch: unexpected shapes (n_in %d out %d ws %zu)\n", n_in, out_size, ws_size); grid = -1; return; }
        int dev = 0, cus = 0, per_cu = 0;
        if (hipGetDevice(&dev) != hipSuccess || hipDeviceGetAttribute(&cus, hipDeviceAttributeMultiprocessorCount, dev) != hipSuccess) { grid = -1; return; }
        if (hipFuncSetAttribute((const void*)mk_fwd, hipFuncAttributeMaxDynamicSharedMemorySize, LDS_BYTES) != hipSuccess) { fprintf(stderr, "kernel_launch: hipFuncSetAttribute failed\n"); grid = -1; return; }
        if (hipOccupancyMaxActiveBlocksPerMultiprocessor(&per_cu, (const void*)mk_fwd, NWAVES * 64, LDS_BYTES) != hipSuccess || per_cu < 1) { fprintf(stderr, "kernel_launch: occupancy query reports %d\n", per_cu); }
        (void)hipGetLastError();
        grid = cus;
    }
    if (grid < 0) return;
    if (hipMemsetAsync((char*)d_ws + WS_CTL, 0, CTL_ZERO_BYTES, stream) != hipSuccess) return;
    Args a{};
    for (int i = 0; i < 14; ++i) a.in[i] = (const float*)d_in[i];
    a.out = (float*)d_out; a.ws = (unsigned char*)d_ws;
    hipLaunchKernelGGL(mk_fwd, dim3(grid), dim3(NWAVES * 64), LDS_BYTES, stream, a);
}
```

```cpp
#include <hip/hip_runtime.h>
#include <cstdint>
#include <cstdio>

namespace pg8 {
#define PG8_LAS __attribute__((address_space(3)))
#define PG8_GAS __attribute__((address_space(1)))
typedef unsigned short bf16_t;
typedef short bf16x8 __attribute__((ext_vector_type(8)));
typedef float f32x4 __attribute__((ext_vector_type(4)));
typedef unsigned u32x4 __attribute__((ext_vector_type(4)));
typedef unsigned u32x2 __attribute__((ext_vector_type(2)));
constexpr int BM = 256, BK = 64, HALF = 128, HTB = HALF * BK * 2  , STAGE_BYTES = 8 * HTB, NXCD = 8, WGM = 8;

__host__ __device__ __forceinline__ int lds_byte(int r, int c) { const int st = (r >> 4) * 2 + (c >> 5), rr = r & 15, cc = c & 31, ob = rr * 64 + cc * 2; return st * 1024 + (ob ^ (((ob >> 9) & 1) << 5)); }
__host__ __device__ __forceinline__ void stage_rc(int b, int& R, int& C) { const int st = b / 1024, sb = b % 1024, swz = sb ^ (((sb >> 9) & 1) << 5); R = (st >> 1) * 16 + swz / 64; C = (st & 1) * 32 + (swz % 64) / 2; }
__host__ __device__ __forceinline__ int perm32(int rho) { const int n = rho >> 4, i = rho & 15; return 8 * (i >> 2) + 4 * n + (i & 3); }

struct Unit { int pm, pn, idx; };
struct Gemm { const bf16_t* A; const bf16_t* Bt; int M, N, K; };

struct StaticOrder {
    int nM, nN, nwg, G, c;
    __host__ __device__ void init(int M, int N, int G_, int c_) { nM = M / BM; nN = N / BM; nwg = nM * nN; G = G_; c = c_; }
    __host__ __device__ bool next(int i, Unit& u) const {
        const long L = (long)i * G + c; if (L >= nwg) return false;
        int wgid = (int)L; { const int q = nwg / NXCD, r = nwg % NXCD, xcd = wgid % NXCD, off = wgid / NXCD; wgid = (xcd < r ? xcd * (q + 1) : r * (q + 1) + (xcd - r) * q) + off; }
        const int nig = WGM * nN, gid = wgid / nig, fm = gid * WGM, gsz = (nM - fm) < WGM ? (nM - fm) : WGM;
        u.pm = fm + ((wgid % nig) % gsz); u.pn = (wgid % nig) / gsz; u.idx = i; return true;
    }
    __device__ __forceinline__ void a_ready(const Unit&) const {}
    __device__ __forceinline__ void done(const Unit&) const {}
};

__device__ __forceinline__ unsigned cvt_pk_bf16(float lo, float hi) { unsigned r; asm volatile("v_cvt_pk_bf16_f32 %0, %1, %2" : "=v"(r) : "v"(lo), "v"(hi)); return r; }

struct EpiRowScaleBf16 {
    static constexpr bool PERM = true, AFTER_DRAIN = false, MIDSCALE = false;
    bf16_t* O; bf16_t* O2; int ldc; int split_pn; const float* rs; const float* slots;
    __device__ __forceinline__ void operator()(const f32x4 (&acc)[2][2][4][2], const Unit& u, int wr, int wc, int fr, int fq) const {
        const int row0 = u.pm * BM + wr * 64 + fr; int pn = u.pn; bf16_t* base = O;
        if (pn >= split_pn) { pn -= split_pn; base = O2; }
        const int col0 = pn * BM + wc * 32 + 8 * fq;
        float sc[2][4];
#pragma unroll
        for (int ai = 0; ai < 2; ++ai)
#pragma unroll
            for (int m = 0; m < 4; ++m) {
                const int r = row0 + ai * HALF + m * 16;
                if (rs) sc[ai][m] = *(const PG8_GAS float*)(rs + r);
                else { const PG8_GAS f32x4* sp = (const PG8_GAS f32x4*)(slots + (size_t)r * 32 + fq * 8); const f32x4 a = sp[0], b = sp[1];
                    float s = ((a[0] + a[1]) + (a[2] + a[3])) + ((b[0] + b[1]) + (b[2] + b[3])); s += __shfl_xor(s, 16); s += __shfl_xor(s, 32);
                    sc[ai][m] = 1.0f / sqrtf(s * (1.0f / 2048.0f) + 1e-6f); }
            }
#pragma unroll
        for (int ai = 0; ai < 2; ++ai)
#pragma unroll
            for (int m = 0; m < 4; ++m) { bf16_t* rowp = base + (size_t)(row0 + ai * HALF + m * 16) * ldc + col0; const float s = sc[ai][m];
#pragma unroll
                for (int bj = 0; bj < 2; ++bj) { const f32x4 v0 = acc[ai][bj][m][0] * s, v1 = acc[ai][bj][m][1] * s;
                    u32x4 w; w.x = cvt_pk_bf16(v0[0], v0[1]); w.y = cvt_pk_bf16(v0[2], v0[3]); w.z = cvt_pk_bf16(v1[0], v1[1]); w.w = cvt_pk_bf16(v1[2], v1[3]);
                    *(u32x4*)(rowp + bj * HALF) = w; } }
    }
};
struct EpiResidual {
    static constexpr bool PERM = false, AFTER_DRAIN = false, MIDSCALE = false;
    const float* base; float* out; bf16_t* ob; int ldc; float* slots;
    __device__ __forceinline__ void operator()(const f32x4 (&acc)[2][2][4][2], const Unit& u, int wr, int wc, int fr, int fq) const {
        const int row0 = u.pm * BM + wr * 64 + fr, col0 = u.pn * BM + wc * 32 + 4 * fq;
#pragma unroll
        for (int ai = 0; ai < 2; ++ai)
#pragma unroll
            for (int m = 0; m < 4; ++m) { const int r = row0 + ai * HALF + m * 16; const size_t off = (size_t)r * ldc + col0; float ss = 0.f;
#pragma unroll
                for (int bj = 0; bj < 2; ++bj)
#pragma unroll
                    for (int n = 0; n < 2; ++n) { const f32x4 v = *(const f32x4*)(base + off + bj * HALF + n * 16) + acc[ai][bj][m][n];
                        *(f32x4*)(out + off + bj * HALF + n * 16) = v; ss += (v[0] * v[0] + v[1] * v[1]) + (v[2] * v[2] + v[3] * v[3]);
                        if (ob) { u32x2 w; w.x = cvt_pk_bf16(v[0], v[1]); w.y = cvt_pk_bf16(v[2], v[3]); *(u32x2*)(ob + off + bj * HALF + n * 16) = w; } }
                ss += __shfl_xor(ss, 16); ss += __shfl_xor(ss, 32);
                if (fq == 0) slots[(size_t)r * 32 + u.pn * 4 + wc] = ss; }
    }
};

struct MixOrder : StaticOrder {
    const float* ssY; PG8_LAS float* tab;
    __device__ __forceinline__ void a_ready(const Unit& u) const {
        int tid = threadIdx.x; asm volatile("" : "+v"(tid));
        const int row = tid >> 1, grp = tid & 1;
        const PG8_GAS f32x4* sp = (const PG8_GAS f32x4*)(ssY + (size_t)(u.pm * BM + row) * 32 + grp * 16); const f32x4 a = sp[0], b = sp[1], c = sp[2], d = sp[3];
        const float s = (((a[0] + a[1]) + (a[2] + a[3])) + ((b[0] + b[1]) + (b[2] + b[3]))) + (((c[0] + c[1]) + (c[2] + c[3])) + ((d[0] + d[1]) + (d[2] + d[3])));
        const float o = __shfl_xor(s, 1), sA = grp ? o : s, sB = grp ? s : o;
        const float vA = sA * (1.0f / 1024.0f) + 1e-6f, vB = sB * (1.0f / 1024.0f) + 1e-6f;
        tab[(u.idx & 1) * 512 + tid] = grp ? 1.0f / sqrtf(vB) : sqrtf(vB / vA);
    }
};
struct EpiResidualMix {
    static constexpr bool PERM = false, AFTER_DRAIN = false, MIDSCALE = true;
    const float* base; float* out; bf16_t* ob; int ldc; float* slots; const PG8_LAS float* tab;
    __device__ __forceinline__ void midscale(f32x4 (&acc)[2][2][4][2], const Unit& u, int wr, int wc, int fr, int fq) const {
        const PG8_LAS float* t = tab + (u.idx & 1) * 512 + (wr * 64 + fr) * 2;
#pragma unroll
        for (int ai = 0; ai < 2; ++ai)
#pragma unroll
            for (int m = 0; m < 4; ++m) { const float ratio = t[(ai * HALF + m * 16) * 2];
#pragma unroll
                for (int bj = 0; bj < 2; ++bj)
#pragma unroll
                    for (int n = 0; n < 2; ++n) acc[ai][bj][m][n] *= ratio; }
    }
    __device__ __forceinline__ void operator()(const f32x4 (&acc)[2][2][4][2], const Unit& u, int wr, int wc, int fr, int fq) const {
        const int row0 = u.pm * BM + wr * 64 + fr, col0 = u.pn * BM + wc * 32 + 4 * fq;
        const PG8_LAS float* t = tab + (u.idx & 1) * 512 + (wr * 64 + fr) * 2 + 1;
#pragma unroll
        for (int ai = 0; ai < 2; ++ai)
#pragma unroll
            for (int m = 0; m < 4; ++m) { const int r = row0 + ai * HALF + m * 16; const size_t off = (size_t)r * ldc + col0; float ss = 0.f;
                const float rB = t[(ai * HALF + m * 16) * 2];
#pragma unroll
                for (int bj = 0; bj < 2; ++bj)
#pragma unroll
                    for (int n = 0; n < 2; ++n) { const f32x4 v = *(const PG8_GAS f32x4*)(base + off + bj * HALF + n * 16) + acc[ai][bj][m][n] * rB;
                        *(PG8_GAS f32x4*)(out + off + bj * HALF + n * 16) = v; ss += (v[0] * v[0] + v[1] * v[1]) + (v[2] * v[2] + v[3] * v[3]);
                        u32x2 w; w.x = cvt_pk_bf16(v[0], v[1]); w.y = cvt_pk_bf16(v[2], v[3]); *(PG8_GAS u32x2*)(ob + off + bj * HALF + n * 16) = w; }
                ss += __shfl_xor(ss, 16); ss += __shfl_xor(ss, 32);
                if (fq == 0) slots[(size_t)r * 32 + u.pn * 4 + wc] = ss; }
    }
};

__device__ __forceinline__ float dpp_ror1(float v) { return __builtin_bit_cast(float, __builtin_amdgcn_update_dpp(0, __builtin_bit_cast(int, v), 0x121, 0xf, 0xf, false)); }
__device__ __forceinline__ float dpp_ror2(float v) { return __builtin_bit_cast(float, __builtin_amdgcn_update_dpp(0, __builtin_bit_cast(int, v), 0x122, 0xf, 0xf, false)); }
__device__ __forceinline__ float silu_mul(float gc, float v) { return gc * v * __builtin_amdgcn_rcpf(1.0f + __builtin_amdgcn_exp2f(gc * -1.4426950408889634f)); }
struct EpiConvGlu {
    static constexpr bool PERM = true, AFTER_DRAIN = false, MIDSCALE = false;
    bf16_t* act; int ldc; const float* slots; const float* wconv; const float* bconv; float* GF; float* VF; float* GL;
    __device__ __forceinline__ void operator()(const f32x4 (&acc)[2][2][4][2], const Unit& u, int wr, int wc, int fr, int fq) const {
        const int row0 = u.pm * BM + wr * 64 + fr, col0 = u.pn * HALF + wc * 32 + 8 * fq;
        f32x4 w0[2], w1[2], w2[2], bb[2];
#pragma unroll
        for (int n = 0; n < 2; ++n) { w0[n] = *(const PG8_GAS f32x4*)(wconv + col0 + 4 * n); w1[n] = *(const PG8_GAS f32x4*)(wconv + ldc + col0 + 4 * n); w2[n] = *(const PG8_GAS f32x4*)(wconv + 2 * ldc + col0 + 4 * n); bb[n] = *(const PG8_GAS f32x4*)(bconv + col0 + 4 * n); }
        const bool f0 = fr == 0, f01 = fr < 2;
#pragma unroll
        for (int ai = 0; ai < 2; ++ai) {
            f32x4 g[4][2], v[4][2];
#pragma unroll
            for (int m = 0; m < 4; ++m) { const int r = row0 + ai * HALF + m * 16;
                const PG8_GAS f32x4* sp = (const PG8_GAS f32x4*)(slots + (size_t)r * 32 + fq * 8); const f32x4 a = sp[0], b = sp[1];
                float s = ((a[0] + a[1]) + (a[2] + a[3])) + ((b[0] + b[1]) + (b[2] + b[3])); s += __shfl_xor(s, 16); s += __shfl_xor(s, 32);
                const float sc = 1.0f / sqrtf(s * (1.0f / 2048.0f) + 1e-6f);
#pragma unroll
                for (int n = 0; n < 2; ++n) { g[m][n] = acc[ai][0][m][n] * sc; v[m][n] = acc[ai][1][m][n] * sc; } }
            const int G = (u.pm * BM + ai * HALF + wr * 64) >> 6;
            if (f01) { float* gp = GF + ((size_t)G * 2 + fr) * ldc + col0; float* vp = VF + ((size_t)G * 2 + fr) * ldc + col0;
                *(PG8_GAS f32x4*)gp = g[0][0]; *(PG8_GAS f32x4*)(gp + 4) = g[0][1]; *(PG8_GAS f32x4*)vp = v[0][0]; *(PG8_GAS f32x4*)(vp + 4) = v[0][1]; }
            if (fr >= 14) { float* gp = GL + ((size_t)G * 2 + (fr - 14)) * ldc + col0; *(PG8_GAS f32x4*)gp = g[3][0]; *(PG8_GAS f32x4*)(gp + 4) = g[3][1]; }
            unsigned wpk[4][4];
#pragma unroll
            for (int n = 0; n < 2; ++n)
#pragma unroll
                for (int jp = 0; jp < 2; ++jp) { float o[4][2];
#pragma unroll
                    for (int jj = 0; jj < 2; ++jj) { const int j = 2 * jp + jj; float T[4], U[4];
#pragma unroll
                        for (int m = 0; m < 4; ++m) { T[m] = dpp_ror1(g[m][n][j]); U[m] = dpp_ror2(g[m][n][j]); }
#pragma unroll
                        for (int m = 0; m < 4; ++m) { const float g1 = (m > 0 && f0) ? T[m > 0 ? m - 1 : 0] : T[m], g2 = (m > 0 && f01) ? U[m > 0 ? m - 1 : 0] : U[m];
                            const float gc = bb[n][j] + w0[n][j] * g2 + w1[n][j] * g1 + w2[n][j] * g[m][n][j];
                            o[m][jj] = silu_mul(gc, v[m][n][j]); } }
#pragma unroll
                    for (int m = 0; m < 4; ++m) wpk[m][2 * n + jp] = cvt_pk_bf16(o[m][0], o[m][1]);
                    asm volatile("" ::: "memory"); }
#pragma unroll
            for (int m = 0; m < 4; ++m) { u32x4 w; w.x = wpk[m][0]; w.y = wpk[m][1]; w.z = wpk[m][2]; w.w = wpk[m][3];
                if (m > 0 || !f01) *(u32x4*)(act + (size_t)(row0 + ai * HALF + m * 16) * ldc + col0) = w; }
        }
    }
};

template <class Epi, class Sched, bool ALIGN_EPI = false, bool SP2 = false>
__device__ __forceinline__ void gemm_phase(PG8_LAS unsigned char* lds, const Gemm g, const Sched& S, const Epi& E) {
    int tid = threadIdx.x; asm volatile("" : "+v"(tid));
    const int wid = __builtin_amdgcn_readfirstlane(tid >> 6), lane = tid & 63, wr = wid >> 2, wc = wid & 3, fr = lane & 15, fq = lane >> 4;
    const int K = g.K, nt = K / BK;
    unsigned voffA[2], voffB[2];
#pragma unroll
    for (int i = 0; i < 2; ++i) { int R, C; stage_rc(tid * 16 + i * 8192, R, C); const int Rb = Epi::PERM ? ((R & ~31) + perm32(R & 31)) : R;
        voffA[i] = (unsigned)(R * K + C) * 2u; voffB[i] = (unsigned)(Rb * K + C) * 2u; }
    const size_t kstep = (size_t)(BK * 2);
    const size_t hstep = (size_t)HALF * K * 2;
    const size_t tstep = 2 * hstep;
    const unsigned ldsw = (unsigned)wid * 1024u;
    const int aoff = lds_byte(wr * 64 + fr, fq * 8), boff = lds_byte(wc * 32 + fr, fq * 8);
#define PG8_SA(b, h) (((b) * 2 + (h)) * HTB)
#define PG8_SB(b, h) ((4 + (b) * 2 + (h)) * HTB)
#define PG8_STAGE(bufoff, gbase, voff) do { _Pragma("unroll") for (int _i = 0; _i < 2; ++_i) \
        __builtin_amdgcn_global_load_lds((const unsigned*)((const char*)(gbase) + (voff)[_i]), (PG8_LAS unsigned*)(lds + (bufoff) + ldsw + _i * 8192), 16, 0, 0); } while (0)
#define PG8_LDA(dst, b, h) do { _Pragma("unroll") for (int m = 0; m < 4; ++m) _Pragma("unroll") for (int k = 0; k < 2; ++k) dst[m][k] = *(const PG8_LAS bf16x8*)(lds + PG8_SA(b, h) + aoff + m * 2048 + k * 1024); } while (0)
#define PG8_LDB(dst, b, h) do { _Pragma("unroll") for (int n = 0; n < 2; ++n) _Pragma("unroll") for (int k = 0; k < 2; ++k) dst[n][k] = *(const PG8_LAS bf16x8*)(lds + PG8_SB(b, h) + boff + n * 2048 + k * 1024); } while (0)
#define PG8_MMA(ai, bj, At, Bt) do { __builtin_amdgcn_s_setprio(1); _Pragma("unroll") for (int m = 0; m < 4; ++m) _Pragma("unroll") for (int n = 0; n < 2; ++n) _Pragma("unroll") for (int k = 0; k < 2; ++k) \
        acc[ai][bj][m][n] = __builtin_amdgcn_mfma_f32_16x16x32_bf16(Bt[n][k], At[m][k], acc[ai][bj][m][n], 0, 0, 0); __builtin_amdgcn_s_setprio(0); } while (0)
#define PG8_WAIT_V(n) asm volatile("s_waitcnt vmcnt(" #n ")" ::: "memory")
#define PG8_WAIT_L(n) asm volatile("s_waitcnt lgkmcnt(" #n ")" ::: "memory")
#define PG8_BAR __builtin_amdgcn_s_barrier()
#define PG8_SCHED __builtin_amdgcn_sched_barrier(0)
    Unit cur, nxt; int ui = 0;
    if (!S.next(0, cur)) return;
    f32x4 acc[2][2][4][2];
#pragma unroll
    for (int a = 0; a < 2; ++a)
#pragma unroll
        for (int b = 0; b < 2; ++b)
#pragma unroll
            for (int m = 0; m < 4; ++m)
#pragma unroll
                for (int n = 0; n < 2; ++n) acc[a][b][m][n] = (f32x4){0.f, 0.f, 0.f, 0.f};
    bf16x8 At[4][2], B0[2][2], B1[2][2];
    const char* cA = (const char*)g.A + (size_t)cur.pm * tstep; const char* cB = (const char*)g.Bt + (size_t)cur.pn * tstep;
    S.a_ready(cur);
    if constexpr (SP2) {
        PG8_STAGE(PG8_SB(0, 0), cB, voffB); PG8_STAGE(PG8_SB(0, 1), cB + hstep, voffB); PG8_STAGE(PG8_SA(0, 0), cA, voffA); PG8_STAGE(PG8_SA(0, 1), cA + hstep, voffA);
        if (wr == 1) PG8_BAR;
        PG8_WAIT_V(2); PG8_BAR;
        PG8_STAGE(PG8_SB(1, 0), cB + kstep, voffB); PG8_STAGE(PG8_SA(1, 0), cA + kstep, voffA); PG8_STAGE(PG8_SB(1, 1), cB + hstep + kstep, voffB);
        PG8_WAIT_V(6); PG8_BAR;
    } else {
        PG8_STAGE(PG8_SB(0, 0), cB, voffB); PG8_STAGE(PG8_SA(0, 0), cA, voffA); PG8_STAGE(PG8_SB(0, 1), cB + hstep, voffB); PG8_STAGE(PG8_SA(0, 1), cA + hstep, voffA);
        if (wr == 1) PG8_BAR;
        PG8_WAIT_V(4); PG8_BAR;
        PG8_STAGE(PG8_SB(1, 0), cB + kstep, voffB); PG8_STAGE(PG8_SA(1, 0), cA + kstep, voffA); PG8_STAGE(PG8_SB(1, 1), cB + hstep + kstep, voffB);
        PG8_WAIT_V(6); PG8_BAR;
    }
    for (;;) {
        const bool has_next = S.next(ui + 1, nxt);
        const char* nA = has_next ? (const char*)g.A + (size_t)nxt.pm * tstep : cA; const char* nB = has_next ? (const char*)g.Bt + (size_t)nxt.pn * tstep : cB;
        for (int t = 0; t < nt; t += 2) {
            const bool last = (t == nt - 2);
            const char* a1 = cA + (size_t)(t + 1) * kstep;
            const char* a2 = last ? nA : cA + (size_t)(t + 2) * kstep; const char* b2 = last ? nB : cB + (size_t)(t + 2) * kstep;
            const char* a3 = a2 + kstep; const char* b3 = b2 + kstep;
            if (last && has_next) S.a_ready(nxt);
            if constexpr (Epi::MIDSCALE) { if (t == nt / 2) E.midscale(acc, cur, wr, wc, fr, fq); }
            if constexpr (SP2) {
            PG8_LDB(B0, 0, 0); PG8_LDB(B1, 0, 1); PG8_SCHED; PG8_LDA(At, 0, 0); PG8_STAGE(PG8_SA(1, 1), a1 + hstep, voffA);
            PG8_WAIT_V(8); PG8_WAIT_L(0); PG8_BAR; PG8_MMA(0, 0, At, B0); PG8_MMA(0, 1, At, B1); PG8_BAR; PG8_SCHED;
            PG8_LDA(At, 0, 1); PG8_STAGE(PG8_SB(0, 0), b2, voffB); PG8_STAGE(PG8_SB(0, 1), b2 + hstep, voffB); PG8_STAGE(PG8_SA(0, 0), a2, voffA);
            PG8_WAIT_V(8); PG8_WAIT_L(0); PG8_BAR; PG8_MMA(1, 0, At, B0); PG8_MMA(1, 1, At, B1); PG8_BAR; PG8_SCHED;
            PG8_LDB(B0, 1, 0); PG8_LDB(B1, 1, 1); PG8_SCHED; PG8_LDA(At, 1, 0); PG8_STAGE(PG8_SA(0, 1), a2 + hstep, voffA);
            PG8_WAIT_V(8); PG8_WAIT_L(0); PG8_BAR; PG8_MMA(0, 0, At, B0); PG8_MMA(0, 1, At, B1); PG8_BAR; PG8_SCHED;
            PG8_LDA(At, 1, 1); PG8_STAGE(PG8_SB(1, 0), b3, voffB); PG8_STAGE(PG8_SB(1, 1), b3 + hstep, voffB); PG8_STAGE(PG8_SA(1, 0), a3, voffA);
            PG8_WAIT_V(8); PG8_WAIT_L(0); PG8_BAR; PG8_MMA(1, 0, At, B0); PG8_MMA(1, 1, At, B1); PG8_BAR; PG8_SCHED;
            } else {
            PG8_LDB(B0, 0, 0); PG8_SCHED; PG8_LDA(At, 0, 0); PG8_STAGE(PG8_SA(1, 1), a1 + hstep, voffA);
            PG8_WAIT_L(8); PG8_BAR; PG8_WAIT_L(0); PG8_MMA(0, 0, At, B0); PG8_BAR; PG8_SCHED;
            PG8_LDB(B1, 0, 1); PG8_STAGE(PG8_SB(0, 0), b2, voffB);
            PG8_BAR; PG8_WAIT_L(0); PG8_MMA(0, 1, At, B1); PG8_BAR;
            PG8_LDA(At, 0, 1); PG8_STAGE(PG8_SA(0, 0), a2, voffA);
            PG8_BAR; PG8_WAIT_L(0); PG8_MMA(1, 0, At, B0); PG8_BAR; PG8_SCHED;
            PG8_STAGE(PG8_SB(0, 1), b2 + hstep, voffB);
            PG8_WAIT_V(6); PG8_BAR; PG8_MMA(1, 1, At, B1); PG8_BAR;
            PG8_LDB(B0, 1, 0); PG8_SCHED; PG8_LDA(At, 1, 0); PG8_STAGE(PG8_SA(0, 1), a2 + hstep, voffA);
            PG8_WAIT_L(8); PG8_BAR; PG8_WAIT_L(0); PG8_MMA(0, 0, At, B0); PG8_BAR; PG8_SCHED;
            PG8_LDB(B1, 1, 1); PG8_STAGE(PG8_SB(1, 0), b3, voffB);
            PG8_BAR; PG8_WAIT_L(0); PG8_MMA(0, 1, At, B1); PG8_BAR;
            PG8_LDA(At, 1, 1); PG8_STAGE(PG8_SA(1, 0), a3, voffA);
            PG8_BAR; PG8_WAIT_L(0); PG8_MMA(1, 0, At, B0); PG8_BAR; PG8_SCHED;
            PG8_STAGE(PG8_SB(1, 1), b3 + hstep, voffB);
            PG8_WAIT_V(6); PG8_BAR; PG8_MMA(1, 1, At, B1); PG8_BAR;
            }
        }
        if constexpr (ALIGN_EPI) { if (wr == 0) PG8_BAR; }
        if constexpr (!Epi::AFTER_DRAIN) { E(acc, cur, wr, wc, fr, fq); S.done(cur); }
        if (!has_next) break;
#pragma unroll
        for (int a = 0; a < 2; ++a)
#pragma unroll
            for (int b = 0; b < 2; ++b)
#pragma unroll
                for (int m = 0; m < 4; ++m)
#pragma unroll
                    for (int n = 0; n < 2; ++n) acc[a][b][m][n] = (f32x4){0.f, 0.f, 0.f, 0.f};
        cur = nxt; cA = nA; cB = nB; ++ui;
        if constexpr (ALIGN_EPI) { if (wr == 1) PG8_BAR; }
    }
    PG8_WAIT_V(0);
    if constexpr (!ALIGN_EPI) { if (wr == 0) PG8_BAR; }
    PG8_BAR;
#undef PG8_SA
#undef PG8_SB
#undef PG8_STAGE
#undef PG8_LDA
#undef PG8_LDB
#undef PG8_MMA
#undef PG8_WAIT_V
#undef PG8_WAIT_L
#undef PG8_BAR
#undef PG8_SCHED
}
}

constexpr int NWAVES = 8;
constexpr int M = 16384, DM = 2048, DIN = 4352, DFF = 5632, HD = 64;
constexpr int QA_OFF = 0, KA_OFF = 1024, VA_OFF = 1152, QS_OFF = 1280, KS_OFF = 2304, VS_OFF = 3328;
constexpr float EPS = 1e-6f;

constexpr size_t MiB = 1u << 20;
constexpr size_t WS_CTL = 0, CTL_ZERO_BYTES = 64 * 1024;
constexpr size_t WS_RSTD1 = 1 * MiB;
constexpr size_t WS_SS2 = 2 * MiB, WS_SS3 = 4 * MiB, WS_SSY = 6 * MiB;
constexpr size_t WS_WUP = 8 * MiB;
constexpr size_t WS_WDOWN = 52 * MiB;
constexpr size_t WS_XB = 74 * MiB;
constexpr size_t WS_ACT = 138 * MiB;
constexpr size_t WS_GF = 364 * MiB, WS_VF = 376 * MiB, WS_GL = 388 * MiB;
constexpr size_t WS_WIN = 138 * MiB;
constexpr size_t WS_WOUT = 155 * MiB;
constexpr size_t WS_PROJ = 163 * MiB;
constexpr size_t WS_MIX = 299 * MiB;
constexpr size_t WS_END = 400 * MiB;
constexpr int CW_BAR = 4096;

constexpr int RING_BYTES = 131072, ATT_TAB_OFF = RING_BYTES  , ATT_WSF_OFF = ATT_TAB_OFF + 16384  , LDSCTL_OFF = ATT_WSF_OFF + 2048, MISC_OFF = LDSCTL_OFF + 320, LDS_BYTES = 155648;

#define GAS __attribute__((address_space(1)))
#define LAS __attribute__((address_space(3)))
typedef unsigned short bf16;
typedef unsigned v4u __attribute__((ext_vector_type(4)));
typedef float f32x4 __attribute__((ext_vector_type(4)));
#define LDS_WAIT() asm volatile("s_waitcnt lgkmcnt(0)" ::: "memory")
__device__ __forceinline__ unsigned f2bf(float f) { unsigned u = __builtin_bit_cast(unsigned, f); return (u + 0x7fffu + ((u >> 16) & 1u)) >> 16; }
__device__ __forceinline__ unsigned pk2(float lo, float hi) { return f2bf(lo) | (f2bf(hi) << 16); }
__device__ __forceinline__ float bf2f(unsigned h) { return __builtin_bit_cast(float, h << 16); }
__device__ __forceinline__ float wave_sum(float v) {
#pragma unroll
    for (int o = 1; o < 64; o <<= 1) v += __shfl_xor(v, o);
    return v;
}

#define XB_TMO      128
#define XB_XCNT(j)  (256  + 64 * (j))
#define XB_XSUB(j)  (1280 + 64 * (j))
#define XB_XGEN(j)  (2304 + 64 * (j))
#define XB_TOP      3328
#define XB_TOPGEN   3392
#define XCD_BAR_WORDS 3456
#define XB_SPIN_CAP (1u << 18)
__device__ __forceinline__ unsigned xb_ld(unsigned* p)              { return __hip_atomic_load(p, __ATOMIC_RELAXED, __HIP_MEMORY_SCOPE_AGENT); }
__device__ __forceinline__ unsigned xb_add(unsigned* p, unsigned v) { return __hip_atomic_fetch_add(p, v, __ATOMIC_RELAXED, __HIP_MEMORY_SCOPE_AGENT); }
__device__ __forceinline__ unsigned xb_xcc_id() { return (unsigned)__builtin_amdgcn_s_getreg((3 << 11) | 20) & 0xFu; }
#define XB_SPIN(cond, bar) do { unsigned _sp = 0; while (cond) { __builtin_amdgcn_s_sleep(1); \
    if ((++_sp & 255u) == 0u) { if (xb_ld(&(bar)[XB_TMO])) break; if (_sp > XB_SPIN_CAP) { atomicAdd(&(bar)[XB_TMO], 1u); break; } } } } while (0)
struct XcdBarrier { unsigned* bar; unsigned x; volatile LAS unsigned* st; };
__device__ __forceinline__ XcdBarrier xcd_barrier_post(unsigned* bar, volatile LAS unsigned* st) {
    XcdBarrier b; b.bar = bar; b.x = xb_xcc_id(); b.st = st;
    if (threadIdx.x == 0) (void)xb_add(&bar[XB_XCNT(b.x)], 1u);
    return b;
}
__device__ __forceinline__ void xcd_barrier_complete(unsigned* bar, unsigned x, unsigned& nloc, unsigned& nx) {
    const unsigned G = gridDim.x * gridDim.y * gridDim.z;
    unsigned sum, cnt, mine, sp = 0u;
    for (;;) {
        sum = 0u; cnt = 0u; mine = 0u;
#pragma unroll
        for (unsigned j = 0; j < 16; ++j) { const unsigned c = xb_ld(&bar[XB_XCNT(j)]); sum += c; cnt += (c > 0u) ? 1u : 0u; mine = (j == x) ? c : mine; }
        if (sum == G) break;
        __builtin_amdgcn_s_sleep(1);
        if ((++sp & 255u) == 0u) { if (xb_ld(&bar[XB_TMO])) break; if (sp > XB_SPIN_CAP) { atomicAdd(&bar[XB_TMO], 1u); break; } }
    }
    nloc = mine > 0u ? mine : 1u; nx = cnt > 0u ? cnt : 1u;
}
__device__ __forceinline__ void xcd_barrier(const XcdBarrier& b) {
    asm volatile("s_waitcnt vmcnt(0)" ::: "memory");
    __syncthreads();
    if (threadIdx.x == 0) {
        unsigned* bar = b.bar;
        __builtin_amdgcn_s_waitcnt(0);
        unsigned nloc = b.st[0], nx = b.st[1];
        if (nloc == 0u) { xcd_barrier_complete(bar, b.x, nloc, nx); b.st[0] = nloc; b.st[1] = nx; }
        const unsigned old = xb_add(&bar[XB_XSUB(b.x)], 1u);
        const unsigned gen = old / nloc;
        if (old + 1u == (gen + 1u) * nloc) {
            __builtin_amdgcn_fence(__ATOMIC_RELEASE, "agent");
            asm volatile("s_waitcnt vmcnt(0)" ::: "memory");
            const unsigned og = xb_add(&bar[XB_TOP], 1u);
            const unsigned tg = og / nx;
            if (og + 1u == (tg + 1u) * nx) xb_add(&bar[XB_TOPGEN], 1u);
            else XB_SPIN(xb_ld(&bar[XB_TOPGEN]) == tg, bar);
            __builtin_amdgcn_fence(__ATOMIC_ACQUIRE, "agent");
            xb_add(&bar[XB_XGEN(b.x)], 1u);
            asm volatile("s_waitcnt vmcnt(0)" ::: "memory");
        } else {
            XB_SPIN(xb_ld(&bar[XB_XGEN(b.x)]) == gen, bar);
            __builtin_amdgcn_fence(__ATOMIC_ACQUIRE, "agent");
            asm volatile("s_waitcnt vmcnt(0)" ::: "memory");
        }
    }
    __syncthreads();
}

__device__ const unsigned char kBucket[128] = {
    0, 1, 2, 3, 4, 5, 6, 7, 8, 9, 10, 11, 12, 13, 14, 15, 16, 16, 16, 17, 17, 18, 18, 18, 19, 19, 19, 20, 20, 20, 20, 21, 21, 21, 21, 22, 22, 22, 22, 22, 23, 23, 23, 23, 23, 23, 24, 24, 24, 24, 24, 24, 25, 25, 25, 25, 25, 25, 25, 26, 26, 26, 26, 26, 26, 26, 26, 27, 27, 27, 27, 27, 27, 27, 27, 27, 27, 28, 28, 28, 28, 28, 28, 28, 28, 28, 28, 29, 29, 29, 29, 29, 29, 29, 29, 29, 29, 29, 29, 30, 30, 30, 30, 30, 30, 30, 30, 30, 30, 30, 30, 30, 30, 31, 31, 31, 31, 31, 31, 31, 31, 31, 31, 31, 31, 31, 31, 31};

__device__ __forceinline__ void p0_transpose_item(const float* W, const float* gk, int K, int N, bf16* WT, LAS float* scr, int item, int lane, bool qscale = false, bool glu_rows = false) {
    const int nblk = N / 64, kb = item / nblk, nb = item % nblk, k0 = 64 * kb, n0 = 64 * nb;
    const float cs = (qscale && (n0 < 1024 || (n0 >= QS_OFF && n0 < KS_OFF))) ? 0.125f * 1.4426950408889634f : 1.0f;
    f32x4 v[16];
#pragma unroll
    for (int i = 0; i < 16; ++i) v[i] = *(const GAS f32x4*)(W + (size_t)(k0 + 4 * i + (lane >> 4)) * N + n0 + (lane & 15) * 4);
#pragma unroll
    for (int i = 0; i < 16; ++i) { const int kk = 4 * i + (lane >> 4); const float g = gk ? gk[k0 + kk] * cs : cs; LAS float* d = scr + kk * 65 + (lane & 15) * 4;
        d[0] = v[i][0] * g; d[1] = v[i][1] * g; d[2] = v[i][2] * g; d[3] = v[i][3] * g; }
    LDS_WAIT(); asm volatile("" ::: "memory");
    const int c = lane & 7;
#pragma unroll
    for (int j = 0; j < 8; ++j) { const int n = (lane >> 3) + 8 * j; const LAS float* s = scr + (8 * c) * 65 + n;
        v4u o; o.x = pk2(s[0 * 65], s[1 * 65]); o.y = pk2(s[2 * 65], s[3 * 65]); o.z = pk2(s[4 * 65], s[5 * 65]); o.w = pk2(s[6 * 65], s[7 * 65]);
        int nrow = n0 + n; if (glu_rows) { const int hv = nrow >= DFF, n2 = hv ? nrow - DFF : nrow; nrow = 256 * (n2 >> 7) + 128 * hv + (n2 & 127); }
        *(GAS v4u*)(WT + (size_t)nrow * K + k0 + 8 * c) = o; }
    LDS_WAIT(); asm volatile("" ::: "memory");
}
__device__ __forceinline__ void row_cvt(const float* xrow, bf16* orow, float* rstd, int lane) {
    const f32x4* xr = (const f32x4*)xrow + lane;
    f32x4 v[8]; float s = 0.f;
#pragma unroll
    for (int j = 0; j < 8; ++j) { v[j] = xr[64 * j]; s += (v[j].x * v[j].x + v[j].y * v[j].y) + (v[j].z * v[j].z + v[j].w * v[j].w); }
    s = wave_sum(s);
    if (lane == 0) *rstd = 1.0f / sqrtf(s * (1.0f / DM) + EPS);
    unsigned long long* o8 = (unsigned long long*)orow + lane;
#pragma unroll
    for (int j = 0; j < 8; ++j) o8[64 * j] = (unsigned long long)pk2(v[j].x, v[j].y) | ((unsigned long long)pk2(v[j].z, v[j].w) << 32);
}

namespace att {
typedef short bf16x8 __attribute__((ext_vector_type(8)));
typedef short s16x4 __attribute__((ext_vector_type(4)));
typedef short v4i16_t __attribute__((ext_vector_type(4)));
typedef float f32x16 __attribute__((ext_vector_type(16)));
typedef unsigned u32x4 __attribute__((ext_vector_type(4)));
typedef float f32x2_t __attribute__((ext_vector_type(2))); typedef __bf16 bf16x2_t __attribute__((ext_vector_type(2)));
typedef LAS const char* lds_cptr;
constexpr float LOG2E = 1.4426950408889634f;
constexpr float QSCALE = 0.125f * LOG2E;
constexpr float SB_EXIT = 150.2f;
__device__ __forceinline__ int crow(int r, int hi) { return (r & 3) + 8 * (r >> 2) + 4 * hi; }
__device__ __forceinline__ unsigned cvtpk(float lo, float hi) { f32x2_t v = {lo, hi}; bf16x2_t b = __builtin_convertvector(v, bf16x2_t); return __builtin_bit_cast(unsigned, b); }
__device__ __forceinline__ s16x4 vtr(lds_cptr p) { return __builtin_bit_cast(s16x4, __builtin_amdgcn_ds_read_tr16_b64_v4i16((LAS v4i16_t*)p)); }
#define ATT_WAITV(n) asm volatile("s_waitcnt vmcnt(" #n ")" ::: "memory")
#define ATT_WAITL() asm volatile("s_waitcnt lgkmcnt(0)" ::: "memory")

__device__ __forceinline__ unsigned k_voff(int lane, int odd) { const int sw = (lane >> 4) + 4 * odd, c = (lane & 7) ^ sw; return (unsigned)((lane >> 3) * DIN * 2 + c * 16); }
__device__ __forceinline__ void dma_k(const bf16* src, LAS unsigned char* kreg, unsigned vk0, unsigned vk1) {
#pragma unroll
    for (int i = 0; i < 8; ++i) { const char* ub = (const char*)src + (size_t)i * (8 * DIN * 2);
        __builtin_amdgcn_global_load_lds((const unsigned*)(ub + ((i & 1) ? vk1 : vk0)), (LAS unsigned*)(kreg + i * 1024), 16, 0, 0); }
}
__device__ __forceinline__ unsigned v_voff(int lane) { return (unsigned)((lane >> 2) * DIN * 2 + (lane & 3) * 16); }
__device__ __forceinline__ void dma_v(const bf16* src, LAS unsigned char* vreg, unsigned vv) {
#pragma unroll
    for (int p = 0; p < 8; ++p) { const char* ub = (const char*)src + (size_t)(p & 3) * (16 * DIN * 2) + (p >> 2) * 64;
        __builtin_amdgcn_global_load_lds((const unsigned*)(ub + vv), (LAS unsigned*)(vreg + p * 1024), 16, 0, 0); }
}
__device__ __forceinline__ void load_kf(bf16x8 (&kf)[8], lds_cptr kreg, int r32, int hi) {
    const lds_cptr kp = kreg + r32 * 128; const int sw = (r32 >> 1) & 7;
#pragma unroll
    for (int d0 = 0; d0 < 4; ++d0) { const int off = ((2 * d0 + hi) ^ sw) * 16;
        kf[2 * d0] = *(const LAS bf16x8*)(kp + off); kf[2 * d0 + 1] = *(const LAS bf16x8*)(kp + 4096 + off); }
}
__device__ __forceinline__ void qkt(f32x16& p0, f32x16& p1, const bf16x8 (&kf)[8], const bf16x8 (&qr)[4]) {
    const f32x16 z = {};
    p0 = __builtin_amdgcn_mfma_f32_32x32x16_bf16(kf[0], qr[0], z, 0, 0, 0); p1 = __builtin_amdgcn_mfma_f32_32x32x16_bf16(kf[1], qr[0], z, 0, 0, 0);
#pragma unroll
    for (int d0 = 1; d0 < 4; ++d0) { p0 = __builtin_amdgcn_mfma_f32_32x32x16_bf16(kf[2 * d0], qr[d0], p0, 0, 0, 0); p1 = __builtin_amdgcn_mfma_f32_32x32x16_bf16(kf[2 * d0 + 1], qr[d0], p1, 0, 0, 0); }
}
__device__ __forceinline__ void pv(f32x16 (&o)[2], lds_cptr vp0, const f32x16& p0, const f32x16& p1) {
    u32x4 pw[4];
#pragma unroll
    for (int j = 0; j < 4; ++j) { pw[0][j] = cvtpk(p0[2 * j], p0[2 * j + 1]); pw[1][j] = cvtpk(p0[8 + 2 * j], p0[9 + 2 * j]); pw[2][j] = cvtpk(p1[2 * j], p1[2 * j + 1]); pw[3][j] = cvtpk(p1[8 + 2 * j], p1[9 + 2 * j]); }
#pragma unroll
    for (int d0 = 0; d0 < 2; ++d0)
#pragma unroll
        for (int ks = 0; ks < 4; ++ks) { const s16x4 lo = vtr(vp0 + d0 * 4096 + ks * 1024), hi4 = vtr(vp0 + d0 * 4096 + ks * 1024 + 512);
            const bf16x8 vf = (bf16x8){lo[0], lo[1], lo[2], lo[3], hi4[0], hi4[1], hi4[2], hi4[3]};
            o[d0] = __builtin_amdgcn_mfma_f32_32x32x16_bf16(__builtin_bit_cast(bf16x8, pw[ks]), vf, o[d0], 0, 0, 0); }
}
__device__ __forceinline__ float swap_other(float v) { auto rr = __builtin_amdgcn_permlane32_swap(__float_as_uint(v), __float_as_uint(v), false, false); return (threadIdx.x & 32) ? __uint_as_float(rr[0]) : __uint_as_float(rr[1]); }

template <bool SCALE> __device__ __forceinline__ void store_o(const f32x16 (&o)[2], LAS unsigned char* kreg, LAS float* wsf, bf16* y, float* slots, int tok0, int col0, int slot, int lane) {
    const int r32 = lane & 31, hi = lane >> 5;
    LAS float* stg = (LAS float*)kreg;
#pragma unroll
    for (int r = 0; r < 16; ++r) { const int row = crow(r, hi); stg[row * 64 + r32] = o[0][r]; stg[row * 64 + 32 + r32] = o[1][r]; }
    ATT_WAITL();
#pragma unroll
    for (int i = 0; i < 4; ++i) { const int row = i * 8 + (lane >> 3), ch = lane & 7;
        const f32x4 a = *(const LAS f32x4*)(stg + row * 64 + ch * 8), b = *(const LAS f32x4*)(stg + row * 64 + ch * 8 + 4);
        const float s = SCALE ? wsf[32 + row] : 1.0f;
        const f32x4 a2 = a * s, b2 = b * s;
        float ss = ((a2[0] * a2[0] + a2[1] * a2[1]) + (a2[2] * a2[2] + a2[3] * a2[3])) + ((b2[0] * b2[0] + b2[1] * b2[1]) + (b2[2] * b2[2] + b2[3] * b2[3]));
        ss += __shfl_xor(ss, 1); ss += __shfl_xor(ss, 2); ss += __shfl_xor(ss, 4);
        v4u w; w.x = cvtpk(a2[0], a2[1]); w.y = cvtpk(a2[2], a2[3]); w.z = cvtpk(b2[0], b2[1]); w.w = cvtpk(b2[2], b2[3]);
        *(GAS v4u*)(y + (size_t)(tok0 + row) * DM + col0 + ch * 8) = w;
        if (ch == 0) *(GAS float*)(slots + (size_t)(tok0 + row) * 32 + slot) = ss; }
    ATT_WAITL();
}

__device__ __forceinline__ void swa_item(const bf16* proj, LAS unsigned char* kreg, LAS unsigned char* vreg, LAS float* wsf, const LAS float* tab, float sink2, bf16* y, float* slots, int h, int q0, int lane) {
    const int r32 = lane & 31, hi = lane >> 5, kvh = h >> 3;
    const bf16* Kb = proj + KA_OFF + kvh * HD; const bf16* Vb = proj + VA_OFF + kvh * HD;
    const int kt_hi = q0 >> 6; int kt = kt_hi - 2 < 0 ? 0 : kt_hi - 2;
    const unsigned vk0 = k_voff(lane, 0), vk1 = k_voff(lane, 1), vv = v_voff(lane);
    dma_k(Kb + (size_t)kt * 64 * DIN, kreg, vk0, vk1); dma_v(Vb + (size_t)kt * 64 * DIN, vreg, vv);
    bf16x8 qr[4];
#pragma unroll
    for (int d0 = 0; d0 < 4; ++d0) qr[d0] = *(const GAS bf16x8*)(proj + (size_t)(q0 + r32) * DIN + QA_OFF + h * HD + d0 * 16 + hi * 8);
    const lds_cptr vp0 = (lds_cptr)vreg + ((lane >> 4) & 1) * 32 + (lane & 3) * 8 + (4 * hi + ((lane & 15) >> 2)) * 64;
    f32x16 o[2]; o[0] = f32x16{}; o[1] = f32x16{};
    float m = sink2, l = hi ? 0.f : 1.0f;
    const LAS float* tb = tab + h * 256;
    for (;; ++kt) {
        const bool more = kt < kt_hi;
        ATT_WAITV(8);
        bf16x8 kf[8]; load_kf(kf, (lds_cptr)kreg, r32, hi); ATT_WAITL();
        if (more) dma_k(Kb + (size_t)(kt + 1) * 64 * DIN, kreg, vk0, vk1);
        f32x16 p0, p1; qkt(p0, p1, kf, qr);
        const LAS float* t0 = tb + (191 - (q0 + r32 - 64 * kt - 4 * hi));
#pragma unroll
        for (int r = 0; r < 16; ++r) { const int cr = (r & 3) + 8 * (r >> 2); p0[r] += t0[cr]; p1[r] += t0[32 + cr]; }
        float rm = fmaxf(p0[0], p1[0]);
#pragma unroll
        for (int r = 1; r < 16; ++r) rm = fmaxf(rm, fmaxf(p0[r], p1[r]));
        rm = fmaxf(rm, swap_other(rm));
        const float mn = fmaxf(m, rm), f = __builtin_amdgcn_exp2f(m - mn); m = mn;
        float ps = 0.f;
#pragma unroll
        for (int r = 0; r < 16; ++r) { p0[r] = __builtin_amdgcn_exp2f(p0[r] - mn); p1[r] = __builtin_amdgcn_exp2f(p1[r] - mn); ps += p0[r] + p1[r]; }
        l = l * f + ps;
        if (__any(f != 1.0f)) {
            if (hi == 0) wsf[r32] = f;
            ATT_WAITL();
#pragma unroll
            for (int r = 0; r < 16; ++r) { const float fr_ = wsf[crow(r, hi)]; o[0][r] *= fr_; o[1][r] *= fr_; }
            ATT_WAITL();
        }
        if (more) ATT_WAITV(8); else ATT_WAITV(0);
        pv(o, vp0, p0, p1); ATT_WAITL();
        if (!more) break;
        dma_v(Vb + (size_t)(kt + 1) * 64 * DIN, vreg, vv);
    }
    l += swap_other(l);
    if (hi == 0) wsf[32 + r32] = 1.0f / l;
    ATT_WAITL();
    store_o<true>(o, kreg, wsf, y, slots, q0, h * HD, h, lane);
}

__device__ __forceinline__ void sb_item(const bf16* proj, LAS unsigned char* kreg, LAS unsigned char* vreg, bf16* y, float* slots, int h, int q0, int lane) {
    const int r32 = lane & 31, hi = lane >> 5;
    const bf16* Kb = proj + KS_OFF + h * HD; const bf16* Vb = proj + VS_OFF + h * HD;
    int kt = q0 >> 6;
    const unsigned vk0 = k_voff(lane, 0), vk1 = k_voff(lane, 1), vv = v_voff(lane);
    dma_k(Kb + (size_t)kt * 64 * DIN, kreg, vk0, vk1); dma_v(Vb + (size_t)kt * 64 * DIN, vreg, vv);
    bf16x8 qr[4];
#pragma unroll
    for (int d0 = 0; d0 < 4; ++d0) qr[d0] = *(const GAS bf16x8*)(proj + (size_t)(q0 + r32) * DIN + QS_OFF + h * HD + d0 * 16 + hi * 8);
    const lds_cptr vp0 = (lds_cptr)vreg + ((lane >> 4) & 1) * 32 + (lane & 3) * 8 + (4 * hi + ((lane & 15) >> 2)) * 64;
    f32x16 o[2]; o[0] = f32x16{}; o[1] = f32x16{};
    float R = 0.f;
    bool diag = true;
    for (;; --kt) {
        const bool more = kt > 0;
        ATT_WAITV(8);
        bf16x8 kf[8]; load_kf(kf, (lds_cptr)kreg, r32, hi); ATT_WAITL();
        if (more) dma_k(Kb + (size_t)(kt - 1) * 64 * DIN, kreg, vk0, vk1);
        f32x16 p0, p1; qkt(p0, p1, kf, qr);
        const int qrel = diag ? (q0 + r32 - 64 * kt - 4 * hi) : 1000;
        f32x16 e0, e1; float T[2][4];
#pragma unroll
        for (int r = 0; r < 16; ++r) { const int cr = (r & 3) + 8 * (r >> 2);
            float s0 = fmaxf(p0[r], 0.f) + __builtin_amdgcn_logf(1.0f + __builtin_amdgcn_exp2f(-fabsf(p0[r])));
            float s1 = fmaxf(p1[r], 0.f) + __builtin_amdgcn_logf(1.0f + __builtin_amdgcn_exp2f(-fabsf(p1[r])));
            e0[r] = (cr < qrel) ? s0 : 0.f; e1[r] = (cr + 32 < qrel) ? s1 : 0.f; }
#pragma unroll
        for (int w = 0; w < 4; ++w) { e0[4 * w + 2] += e0[4 * w + 3]; e0[4 * w + 1] += e0[4 * w + 2]; e0[4 * w] += e0[4 * w + 1]; T[0][w] = e0[4 * w];
                                      e1[4 * w + 2] += e1[4 * w + 3]; e1[4 * w + 1] += e1[4 * w + 2]; e1[4 * w] += e1[4 * w + 1]; T[1][w] = e1[4 * w]; }
        float run = R, base[2][4];
#pragma unroll
        for (int u = 1; u >= 0; --u)
#pragma unroll
            for (int w = 3; w >= 0; --w) { const float tp = swap_other(T[u][w]); const float rp = run + tp; base[u][w] = hi ? run : rp; run = rp + T[u][w]; }
#pragma unroll
        for (int r = 0; r < 16; ++r) { const int cr = (r & 3) + 8 * (r >> 2);
            const float a0 = __builtin_amdgcn_exp2f((p0[r] - base[0][r >> 2]) - e0[r]), a1 = __builtin_amdgcn_exp2f((p1[r] - base[1][r >> 2]) - e1[r]);
            p0[r] = (cr < qrel) ? a0 : 0.f; p1[r] = (cr + 32 < qrel) ? a1 : 0.f; }
        R = run;
        if (more) ATT_WAITV(8); else ATT_WAITV(0);
        pv(o, vp0, p0, p1); ATT_WAITL();
        if (!more || __all(R >= SB_EXIT)) break;
        dma_v(Vb + (size_t)(kt - 1) * 64 * DIN, vreg, vv);
        diag = false;
    }
    ATT_WAITV(0);
    store_o<false>(o, kreg, nullptr, y, slots, q0, 1024 + h * HD, 16 + h, lane);
}
#undef ATT_WAITV
#undef ATT_WAITL
}

struct Args { const float* in[14]; float* out; unsigned char* ws; };
__global__ void __launch_bounds__(NWAVES * 64, 2) mk_fwd(Args args) {
    extern __shared__ __attribute__((aligned(16))) unsigned char lds_raw[];
    LAS unsigned char* lds = (LAS unsigned char*)lds_raw;
    volatile LAS unsigned* MISC = (volatile LAS unsigned*)(lds + MISC_OFF);
    const int tid = threadIdx.x;
    const int G = gridDim.x; const int bx = blockIdx.x; const int vcu = (G % 8 == 0) ? (bx % 8) * (G / 8) + bx / 8 : bx;
    unsigned char* ws = args.ws;
    unsigned* ctl = (unsigned*)(ws + WS_CTL);
    const float* x = args.in[0]; const float* w_in = args.in[1]; const float* g_attn = args.in[2]; const float* rel_bias = args.in[3];
    const float* sinks = args.in[4]; const float* g_swa = args.in[5]; const float* g_sb = args.in[6]; const float* w_out = args.in[7];
    const float* g_mlp = args.in[8]; const float* w_up = args.in[9]; const float* w_conv = args.in[10]; const float* b_conv = args.in[11];
    const float* w_down = args.in[12]; const float* g_final = args.in[13];
    float* out = args.out;
    float* rstd1 = (float*)(ws + WS_RSTD1); float* ss2 = (float*)(ws + WS_SS2); float* ss3 = (float*)(ws + WS_SS3);
    bf16* WinT = (bf16*)(ws + WS_WIN); bf16* WoutT = (bf16*)(ws + WS_WOUT); bf16* WupT = (bf16*)(ws + WS_WUP); bf16* WdownT = (bf16*)(ws + WS_WDOWN);
    bf16* xb = (bf16*)(ws + WS_XB); bf16* proj = (bf16*)(ws + WS_PROJ); bf16* mix = (bf16*)(ws + WS_MIX);
    float* ssY = (float*)(ws + WS_SSY);
    bf16* act = (bf16*)(ws + WS_ACT); float* GFb = (float*)(ws + WS_GF); float* VFb = (float*)(ws + WS_VF); float* GLb = (float*)(ws + WS_GL);

    for (int u = tid; u < (LDS_BYTES - LDSCTL_OFF) / 4; u += NWAVES * 64) ((LAS unsigned*)(lds + LDSCTL_OFF))[u] = 0u;
    __syncthreads();
    XcdBarrier bar = xcd_barrier_post(ctl + CW_BAR, MISC + 8);
    const int NGW = G * NWAVES, NGT = G * NWAVES * 64;
#define PHASE_IDS() int tidp = threadIdx.x; asm volatile("" : "+v"(tidp)); const int lane = tidp & 63, wave = __builtin_amdgcn_readfirstlane(tidp >> 6); const int gw = vcu * NWAVES + wave, gt = vcu * (NWAVES * 64) + tidp; (void)lane; (void)gw; (void)gt

#if defined(PROBE_A)
    unsigned long long ts_[12]; int nts_ = 0;
#define STAMP() do { ts_[nts_++] = __builtin_amdgcn_s_memrealtime(); } while (0)
#else
#define STAMP() do { } while (0)
#endif
    STAMP();
#ifndef REP_P0
#define REP_P0 1
#endif
    for (int rep0 = 0; rep0 < REP_P0; ++rep0) {
    {
        PHASE_IDS();
        LAS float* scr = (LAS float*)(lds + wave * 16640);
        constexpr int I_IN = (DM / 64) * (DIN / 64), I_OUT = (DM / 64) * (DM / 64), I_UP = (DM / 64) * (2 * DFF / 64), I_DOWN = (DFF / 64) * (DM / 64);
        constexpr int NITEMS = I_IN + I_OUT + I_UP + I_DOWN;
        for (int it = gw; it < NITEMS; it += NGW) {
            int r = it;
            if (r < I_IN) { p0_transpose_item(w_in, g_attn, DM, DIN, WinT, scr, r, lane, true); continue; } r -= I_IN;
            if (r < I_OUT) { const int k0 = 64 * (r / (DM / 64)); p0_transpose_item(w_out, k0 < 1024 ? g_swa : g_sb - 1024, DM, DM, WoutT, scr, r, lane); continue; } r -= I_OUT;
            if (r < I_UP) { p0_transpose_item(w_up, g_mlp, DM, 2 * DFF, WupT, scr, r, lane, false, true); continue; } r -= I_UP;
            p0_transpose_item(w_down, nullptr, DFF, DM, WdownT, scr, r, lane);
        }
        for (int m = gw; m < M; m += NGW) row_cvt(x + (size_t)m * DM, xb + (size_t)m * DM, rstd1 + m, lane);
    }
    xcd_barrier(bar); STAMP();
    }

#ifndef REP_P1
#define REP_P0 1
#define REP_P1 1
#define REP_P2 1
#define REP_P4 1
#endif
    for (int rep = 0; rep < REP_P1; ++rep) {
    {
        pg8::Gemm g{xb, WinT, M, DIN, DM}; pg8::StaticOrder S; S.init(M, DIN, G, bx);
        pg8::EpiRowScaleBf16 E{proj, proj, DIN, 1 << 30, rstd1, nullptr};
        pg8::gemm_phase<pg8::EpiRowScaleBf16, pg8::StaticOrder, true, true>(lds, g, S, E);
    }
    xcd_barrier(bar); STAMP();
    }

    for (int rep = 0; rep < REP_P2; ++rep) {
    {
        PHASE_IDS();
        LAS float* tab = (LAS float*)(lds + ATT_TAB_OFF);
        for (int i = tidp; i < 16 * 256; i += NWAVES * 64) { const int h = i >> 8, dist = 191 - (i & 255);
            tab[i] = (dist >= 0 && dist < 128) ? rel_bias[kBucket[dist] * 16 + h] * att::LOG2E : -1e30f; }
        __syncthreads();
        LAS unsigned char* kreg = lds + wave * 16384; LAS unsigned char* vreg = kreg + 8192; LAS float* wsf = (LAS float*)(lds + ATT_WSF_OFF) + wave * 64;
        for (int tb = vcu; tb < M / 64; tb += G) {
            const int q0 = 64 * tb + 32 * (wave & 1);
            for (int hh = 0; hh < 4; ++hh) { const int h = 4 * (wave >> 1) + hh; att::swa_item(proj, kreg, vreg, wsf, tab, sinks[h] * att::LOG2E, mix, ssY, h, q0, lane); }
            for (int hh = 0; hh < 4; ++hh) { const int h = 4 * (wave >> 1) + hh; att::sb_item(proj, kreg, vreg, mix, ssY, h, q0, lane); }
        }
    }
    xcd_barrier(bar); STAMP();
    }

    {
        pg8::Gemm g{mix, WoutT, M, DM, DM}; pg8::MixOrder S; S.init(M, DM, G, bx); S.ssY = ssY; S.tab = (LAS float*)(lds + ATT_TAB_OFF);
        pg8::EpiResidualMix E{x, out, xb, DM, ss2, (const LAS float*)(lds + ATT_TAB_OFF)};
        pg8::gemm_phase<pg8::EpiResidualMix, pg8::MixOrder, true, true>(lds, g, S, E);
    }
    xcd_barrier(bar); STAMP();

    for (int rep = 0; rep < REP_P4; ++rep) {
    {
        pg8::Gemm g{xb, WupT, M, 2 * DFF, DM}; pg8::StaticOrder S; S.init(M, 2 * DFF, G, bx);
        pg8::EpiConvGlu E{act, DFF, ss2, w_conv, b_conv, GFb, VFb, GLb};
        pg8::gemm_phase<pg8::EpiConvGlu, pg8::StaticOrder, true, true>(lds, g, S, E);
    }
    xcd_barrier(bar); STAMP();
    }

    { PHASE_IDS();
    for (int i = gt; i < (M / 64) * 2 * (DFF / 4); i += NGT) {
        const int c = (i % (DFF / 4)) * 4, gi = i / (DFF / 4), Gg = gi >> 1, ri = gi & 1;
        const f32x4 z = (f32x4){0.f, 0.f, 0.f, 0.f};
        const f32x4 gv = *(const f32x4*)(GFb + ((size_t)Gg * 2 + ri) * DFF + c), vv = *(const f32x4*)(VFb + ((size_t)Gg * 2 + ri) * DFF + c);
        const f32x4 l1 = Gg > 0 ? *(const f32x4*)(GLb + ((size_t)(Gg - 1) * 2 + 1) * DFF + c) : z, l0 = Gg > 0 ? *(const f32x4*)(GLb + ((size_t)(Gg - 1) * 2 + 0) * DFF + c) : z;
        const f32x4 g1 = ri ? *(const f32x4*)(GFb + ((size_t)Gg * 2) * DFF + c) : l1, g2 = ri ? l1 : l0;
        const f32x4 w0 = *(const f32x4*)(w_conv + c), w1 = *(const f32x4*)(w_conv + DFF + c), w2 = *(const f32x4*)(w_conv + 2 * DFF + c), bb = *(const f32x4*)(b_conv + c);
        float o[4];
#pragma unroll
        for (int j = 0; j < 4; ++j) o[j] = pg8::silu_mul(bb[j] + w0[j] * g2[j] + w1[j] * g1[j] + w2[j] * gv[j], vv[j]);
        *(unsigned long long*)(act + (size_t)(Gg * 64 + ri) * DFF + c) = (unsigned long long)pk2(o[0], o[1]) | ((unsigned long long)pk2(o[2], o[3]) << 32);
    } }
    xcd_barrier(bar); STAMP();

    {
        pg8::Gemm g{act, WdownT, M, DM, DFF}; pg8::StaticOrder S; S.init(M, DM, G, bx);
        pg8::EpiResidual E{out, out, nullptr, DM, ss3};
        pg8::gemm_phase<pg8::EpiResidual, pg8::StaticOrder, true, true>(lds, g, S, E);
    }
    xcd_barrier(bar); STAMP();

    {
        PHASE_IDS();
        const unsigned tmo = xb_ld(ctl + CW_BAR + XB_TMO);
        for (int m = gw; m < M; m += NGW) {
            float s = (lane < 32) ? ss3[(size_t)m * 32 + lane] : 0.f; s = wave_sum(s);
            float r = 1.0f / sqrtf(s * (1.0f / DM) + EPS);
            if (tmo) r = __builtin_nanf("");
            f32x4* xr = (f32x4*)(out + (size_t)m * DM) + lane; const f32x4* gr = (const f32x4*)g_final + lane;
#pragma unroll
            for (int j = 0; j < 8; ++j) { const f32x4 v = xr[64 * j]; xr[64 * j] = v * r * gr[64 * j]; }
        }
    }
#if defined(PROBE_A)
    xcd_barrier(bar); STAMP();
    if (blockIdx.x == 0) {
        const float d1 = (float)(ts_[PROBE_A2] - ts_[PROBE_A]) * 0.01f, d2 = (float)(ts_[PROBE_B2] - ts_[PROBE_B]) * 0.01f;
        if (threadIdx.x == 0) out[0] += d1;
        for (int i = threadIdx.x; i < (1 << 20); i += NWAVES * 64) out[4096 + i] += d2;
    }
#endif
}

extern "C" void kernel_launch(void* const* d_in, const int* in_sizes, int n_in, void* d_out, int out_size, void* d_ws, size_t ws_size, hipStream_t stream) {
    static int grid = 0;
    if (grid == 0) {
        if (n_in != 14 || out_size != M * DM || ws_size < WS_END) { fprintf(stderr, "kernel_launch: unexpected shapes (n_in %d out %d ws %zu)\n", n_in, out_size, ws_size); grid = -1; return; }
        int dev = 0, cus = 0, per_cu = 0;
        if (hipGetDevice(&dev) != hipSuccess || hipDeviceGetAttribute(&cus, hipDeviceAttributeMultiprocessorCount, dev) != hipSuccess) { grid = -1; return; }
        if (hipFuncSetAttribute((const void*)mk_fwd, hipFuncAttributeMaxDynamicSharedMemorySize, LDS_BYTES) != hipSuccess) { fprintf(stderr, "kernel_launch: hipFuncSetAttribute failed\n"); grid = -1; return; }
        if (hipOccupancyMaxActiveBlocksPerMultiprocessor(&per_cu, (const void*)mk_fwd, NWAVES * 64, LDS_BYTES) != hipSuccess || per_cu < 1) { fprintf(stderr, "kernel_launch: occupancy query reports %d\n", per_cu); }
        (void)hipGetLastError();
        grid = cus;
    }
    if (grid < 0) return;
    if (hipMemsetAsync((char*)d_ws + WS_CTL, 0, CTL_ZERO_BYTES, stream) != hipSuccess) return;
    Args a{};
    for (int i = 0; i < 14; ++i) a.in[i] = (const float*)d_in[i];
    a.out = (float*)d_out; a.ws = (unsigned char*)d_ws;
    hipLaunchKernelGGL(mk_fwd, dim3(grid), dim3(NWAVES * 64), LDS_BYTES, stream, a);
}
```
